# Optimizing an MI355X kernel written in HIP

```python
import math
import jax, jax.numpy as jnp
from jax import lax
import numpy as np

D_MODEL = 1024
BATCH = 4
SEQ = 4096
DEPTH = 2

POOL_WINDOWS = (2, 4, 8, 16)
N_POOL_GROUPS = len(POOL_WINDOWS)
POOL_GROUP_DIM = D_MODEL // 8
POOL_WIDTH = N_POOL_GROUPS * POOL_GROUP_DIM

SSD_WIDTH = D_MODEL
SSD_HEAD_DIM = 64
SSD_HEADS = SSD_WIDTH // SSD_HEAD_DIM
SSD_GROUPS = 2
HEADS_PER_GROUP = SSD_HEADS // SSD_GROUPS
SSD_STATE = 128
SSD_CONV = 4
SSD_CHUNK = 128
CONV_DIM = SSD_WIDTH + 2 * SSD_GROUPS * SSD_STATE

MIX_WIDTH = POOL_WIDTH + SSD_WIDTH
IN_PROJ_DIM = POOL_WIDTH + SSD_WIDTH + CONV_DIM + SSD_HEADS

PEER_HEADS = 8
PEER_TOPK = 16
N_KEYS = 128
N_EXPERTS = N_KEYS * N_KEYS
D_KEY = 256
PEER_BLOCK = 128

N_MOD = 6
EPS = 1e-6

kernel_name = "hybrid_pool_ssd_peer_adaln"


def rmsnorm(x, g):
    xf = x.astype(jnp.float32)
    y = xf * lax.rsqrt(jnp.mean(xf * xf, axis=-1, keepdims=True) + EPS)
    return (y * g.astype(jnp.float32)).astype(x.dtype)


def modulate(h, shift, scale):
    return h * (1 + scale[:, None, :]) + shift[:, None, :]


def pool_mixer(u, pool_w, pool_b, pool_scale):
    Bsz, S, _ = u.shape
    ug = u.astype(jnp.float32).reshape(Bsz, S, N_POOL_GROUPS, POOL_GROUP_DIM)
    cs = jnp.cumsum(ug, axis=1)
    t = jnp.arange(S)
    pooled = []
    for gi, w in enumerate(POOL_WINDOWS):
        csg = cs[:, :, gi]
        cs_pad = jnp.pad(csg, ((0, 0), (w, 0), (0, 0)))
        win_sum = cs_pad[:, w:] - cs_pad[:, :S]
        count = jnp.minimum(t + 1, w).astype(jnp.float32)[None, :, None]
        pooled.append(win_sum / count)
    pooled = jnp.stack(pooled, axis=2)
    mixed = pooled - ug
    y = jnp.einsum("bsgc,gcd->bsgd", mixed, pool_w.astype(jnp.float32)) + pool_b.astype(jnp.float32)
    y = y * pool_scale.astype(jnp.float32)
    return y.reshape(Bsz, S, POOL_WIDTH).astype(u.dtype)


def ssd_chunked(xdt, a, b, c):
    Bsz, S, G, R, P = xdt.shape
    N = b.shape[-1]
    L = SSD_CHUNK
    nc = S // L
    xdt = xdt.reshape(Bsz, nc, L, G, R, P)
    b = b.reshape(Bsz, nc, L, G, N)
    c = c.reshape(Bsz, nc, L, G, N)
    a = a.reshape(Bsz, nc, L, G, R).transpose(0, 3, 4, 1, 2)
    a_cs = jnp.cumsum(a, axis=-1)

    causal = jnp.tril(jnp.ones((L, L), dtype=bool))
    seg = a_cs[..., :, None] - a_cs[..., None, :]
    decay = jnp.exp(jnp.where(causal, seg, -jnp.inf))
    cb = jnp.einsum("bclgn,bcsgn->bcgls", c, b)
    y_diag = jnp.einsum("bcgls,bgrcls,bcsgrp->bclgrp", cb, decay, xdt)

    decay_to_end = jnp.exp(a_cs[..., -1:] - a_cs)
    states = jnp.einsum("bclgn,bgrcl,bclgrp->bcgrpn", b, decay_to_end, xdt)
    chunk_decay = jnp.exp(a_cs[..., -1])

    def step(h, inp):
        st, dec = inp
        return h * dec[..., None, None] + st, h

    h0 = jnp.zeros((Bsz, G, R, P, N), jnp.float32)
    _, h_prev = lax.scan(step, h0, (jnp.moveaxis(states, 1, 0), jnp.moveaxis(chunk_decay, -1, 0)))
    y_off = jnp.einsum("bclgn,cbgrpn,bgrcl->bclgrp", c, h_prev, jnp.exp(a_cs))
    return (y_diag + y_off).reshape(Bsz, S, G, R, P)


def ssd_mixer(z, xbc, dt_raw, conv_w, conv_b, dt_bias, a_log, d_skip, ssd_norm):
    Bsz, S, _ = xbc.shape
    dtype = xbc.dtype
    xf = xbc.astype(jnp.float32)
    conv = lax.conv_general_dilated(
        xf, conv_w.astype(jnp.float32).reshape(SSD_CONV, 1, CONV_DIM),
        window_strides=(1,), padding=[(SSD_CONV - 1, 0)],
        dimension_numbers=("NWC", "WIO", "NWC"), feature_group_count=CONV_DIM)
    conv = jax.nn.silu(conv + conv_b.astype(jnp.float32))
    xs = conv[..., :SSD_WIDTH].reshape(Bsz, S, SSD_GROUPS, HEADS_PER_GROUP, SSD_HEAD_DIM)
    bs = conv[..., SSD_WIDTH:SSD_WIDTH + SSD_GROUPS * SSD_STATE].reshape(Bsz, S, SSD_GROUPS, SSD_STATE)
    cs = conv[..., SSD_WIDTH + SSD_GROUPS * SSD_STATE:].reshape(Bsz, S, SSD_GROUPS, SSD_STATE)

    dt = jax.nn.softplus(dt_raw.astype(jnp.float32) + dt_bias.astype(jnp.float32))
    dt = dt.reshape(Bsz, S, SSD_GROUPS, HEADS_PER_GROUP)
    A = -jnp.exp(a_log.astype(jnp.float32)).reshape(SSD_GROUPS, HEADS_PER_GROUP)
    y = ssd_chunked(xs * dt[..., None], dt * A, bs, cs)
    y = y + xs * d_skip.astype(jnp.float32).reshape(SSD_GROUPS, HEADS_PER_GROUP)[..., None]
    y = y.reshape(Bsz, S, SSD_WIDTH) * jax.nn.silu(z.astype(jnp.float32))
    return rmsnorm(y, ssd_norm).astype(dtype)


def peer(h, w_query, sub_keys1, sub_keys2, expert_down, expert_up):
    Bsz, S, D = h.shape
    T = Bsz * S
    hf = h.reshape(T, D)
    q = (hf @ w_query).reshape(T, PEER_HEADS, 2, D_KEY // 2)
    s1 = jnp.einsum("thk,hnk->thn", q[:, :, 0], sub_keys1).astype(jnp.float32)
    s2 = jnp.einsum("thk,hnk->thn", q[:, :, 1], sub_keys2).astype(jnp.float32)
    v1, i1 = lax.top_k(s1, PEER_TOPK)
    v2, i2 = lax.top_k(s2, PEER_TOPK)
    cand = (v1[..., :, None] + v2[..., None, :]).reshape(T, PEER_HEADS, PEER_TOPK * PEER_TOPK)
    cand_idx = (i1[..., :, None] * N_KEYS + i2[..., None, :]).reshape(T, PEER_HEADS, PEER_TOPK * PEER_TOPK)
    top_s, pos = lax.top_k(cand, PEER_TOPK)
    idx = jnp.take_along_axis(cand_idx, pos, axis=-1)
    gates = jax.nn.softmax(top_s, axis=-1).astype(h.dtype)

    nb = T // PEER_BLOCK

    def block_fn(args):
        hb, ib, gb = args
        u = expert_down[ib]
        act = jax.nn.gelu(jnp.einsum("td,thkd->thk", hb, u), approximate=False)
        v = expert_up[ib]
        return jnp.einsum("thk,thkd->td", gb * act, v)

    out = lax.map(block_fn, (hf.reshape(nb, PEER_BLOCK, D),
                             idx.reshape(nb, PEER_BLOCK, PEER_HEADS, PEER_TOPK),
                             gates.reshape(nb, PEER_BLOCK, PEER_HEADS, PEER_TOPK)))
    return out.reshape(Bsz, S, D)


def setup_inputs(seed: int = 0) -> dict:
    key = jax.random.key(seed)
    ks = jax.random.split(key, 24)

    def nrm(k, shape, s):
        return jax.random.normal(k, shape, jnp.float32) * s

    x = nrm(ks[0], (BATCH, SEQ, D_MODEL), 1.0)
    c = nrm(ks[1], (BATCH, D_MODEL), 1.0)
    w_ada = nrm(ks[2], (DEPTH, D_MODEL, N_MOD * D_MODEL), 0.5 * D_MODEL ** -0.5)
    b_ada = nrm(ks[3], (DEPTH, N_MOD * D_MODEL), 0.02)
    norm_mix = 1.0 + nrm(ks[4], (DEPTH, D_MODEL), 0.02)
    norm_ffn = 1.0 + nrm(ks[5], (DEPTH, D_MODEL), 0.02)
    w_in = nrm(ks[6], (DEPTH, D_MODEL, IN_PROJ_DIM), D_MODEL ** -0.5)
    pool_w = nrm(ks[7], (DEPTH, N_POOL_GROUPS, POOL_GROUP_DIM, POOL_GROUP_DIM), POOL_GROUP_DIM ** -0.5)
    pool_b = nrm(ks[8], (DEPTH, N_POOL_GROUPS, POOL_GROUP_DIM), 0.02)
    pool_scale = 1.0 + nrm(ks[9], (DEPTH, N_POOL_GROUPS, POOL_GROUP_DIM), 0.1)
    conv_w = nrm(ks[10], (DEPTH, SSD_CONV, CONV_DIM), SSD_CONV ** -0.5)
    conv_b = nrm(ks[11], (DEPTH, CONV_DIM), 0.02)
    dt0 = jnp.exp(jax.random.uniform(ks[12], (DEPTH, SSD_HEADS), jnp.float32,
                                     minval=math.log(1e-3), maxval=math.log(1e-1)))
    dt_bias = dt0 + jnp.log(-jnp.expm1(-dt0))
    a_log = jnp.log(jax.random.uniform(ks[13], (DEPTH, SSD_HEADS), jnp.float32, minval=1.0, maxval=16.0))
    d_skip = 1.0 + nrm(ks[14], (DEPTH, SSD_HEADS), 0.1)
    ssd_norm = 1.0 + nrm(ks[15], (DEPTH, SSD_WIDTH), 0.02)
    w_out = nrm(ks[16], (DEPTH, MIX_WIDTH, D_MODEL), MIX_WIDTH ** -0.5)
    w_query = nrm(ks[17], (DEPTH, D_MODEL, PEER_HEADS * D_KEY), D_MODEL ** -0.5)
    sub_keys1 = nrm(ks[18], (DEPTH, PEER_HEADS, N_KEYS, D_KEY // 2), (D_KEY // 2) ** -0.5)
    sub_keys2 = nrm(ks[19], (DEPTH, PEER_HEADS, N_KEYS, D_KEY // 2), (D_KEY // 2) ** -0.5)
    expert_down = nrm(ks[20], (DEPTH, N_EXPERTS, D_MODEL), D_MODEL ** -0.5)
    expert_up = nrm(ks[21], (DEPTH, N_EXPERTS, D_MODEL), PEER_HEADS ** -0.5)
    norm_final = 1.0 + nrm(ks[22], (D_MODEL,), 0.02)
    return {"x": x, "c": c, "w_ada": w_ada, "b_ada": b_ada, "norm_mix": norm_mix, "norm_ffn": norm_ffn,
            "w_in": w_in, "pool_w": pool_w, "pool_b": pool_b, "pool_scale": pool_scale,
            "conv_w": conv_w, "conv_b": conv_b, "dt_bias": dt_bias, "a_log": a_log, "d_skip": d_skip,
            "ssd_norm": ssd_norm, "w_out": w_out, "w_query": w_query, "sub_keys1": sub_keys1,
            "sub_keys2": sub_keys2, "expert_down": expert_down, "expert_up": expert_up,
            "norm_final": norm_final}


def reference(x, c, w_ada, b_ada, norm_mix, norm_ffn, w_in, pool_w, pool_b, pool_scale,
              conv_w, conv_b, dt_bias, a_log, d_skip, ssd_norm, w_out, w_query, sub_keys1,
              sub_keys2, expert_down, expert_up, norm_final):
    Bsz = x.shape[0]
    c_act = jax.nn.silu(c)
    s_z = POOL_WIDTH
    s_xbc = POOL_WIDTH + SSD_WIDTH
    s_dt = POOL_WIDTH + SSD_WIDTH + CONV_DIM
    for l in range(DEPTH):
        mod = (c_act @ w_ada[l] + b_ada[l]).reshape(Bsz, N_MOD, D_MODEL)
        shift_m, scale_m, gate_m, shift_f, scale_f, gate_f = [mod[:, i] for i in range(N_MOD)]

        h = modulate(rmsnorm(x, norm_mix[l]), shift_m, scale_m)
        proj = h @ w_in[l]
        y_pool = pool_mixer(proj[..., :s_z], pool_w[l], pool_b[l], pool_scale[l])
        y_ssd = ssd_mixer(proj[..., s_z:s_xbc], proj[..., s_xbc:s_dt], proj[..., s_dt:],
                          conv_w[l], conv_b[l], dt_bias[l], a_log[l], d_skip[l], ssd_norm[l])
        y = jnp.concatenate([y_pool, y_ssd], axis=-1) @ w_out[l]
        x = x + gate_m[:, None, :] * y

        h = modulate(rmsnorm(x, norm_ffn[l]), shift_f, scale_f)
        y = peer(h, w_query[l], sub_keys1[l], sub_keys2[l], expert_down[l], expert_up[l])
        x = x + gate_f[:, None, :] * y
    return rmsnorm(x, norm_final)
```

```cpp
#include <hip/hip_runtime.h>
#include <cstdio>
#include <cstdint>
namespace pg8 {
#define PG8_LAS __attribute__((address_space(3)))
typedef unsigned short bf16_t;
typedef short bf16x8 __attribute__((ext_vector_type(8)));
typedef float f32x4 __attribute__((ext_vector_type(4)));
typedef unsigned u32x4 __attribute__((ext_vector_type(4)));
constexpr int BM = 256, BK = 64, HALF = 128, HTB = HALF * BK * 2  , STAGE_BYTES = 8 * HTB, NXCD = 8, WGM = 8;

__host__ __device__ __forceinline__ int lds_byte(int r, int c) { const int st = (r >> 4) * 2 + (c >> 5), rr = r & 15, cc = c & 31, ob = rr * 64 + cc * 2; return st * 1024 + (ob ^ (((ob >> 9) & 1) << 5)); }
__host__ __device__ __forceinline__ void stage_rc(int b, int& R, int& C) { const int st = b / 1024, sb = b % 1024, swz = sb ^ (((sb >> 9) & 1) << 5); R = (st >> 1) * 16 + swz / 64; C = (st & 1) * 32 + (swz % 64) / 2; }
__host__ __device__ __forceinline__ int perm32(int rho) { const int n = rho >> 4, i = rho & 15; return 8 * (i >> 2) + 4 * n + (i & 3); }

struct Unit { int pm, pn; };
struct Gemm { const bf16_t* A; const bf16_t* Bt; int M, N, K; };

struct StaticOrder {
    int nM, nN, nwg, G, c;
    __host__ __device__ void init(int M, int N, int G_, int c_) { nM = M / BM; nN = N / BM; nwg = nM * nN; G = G_; c = c_; }
    __host__ __device__ bool next(int i, Unit& u) const {
        const long L = (long)i * G + c; if (L >= nwg) return false;
        int wgid = (int)L; { const int q = nwg / NXCD, r = nwg % NXCD, xcd = wgid % NXCD, off = wgid / NXCD; wgid = (xcd < r ? xcd * (q + 1) : r * (q + 1) + (xcd - r) * q) + off; }
        const int nig = WGM * nN, gid = wgid / nig, fm = gid * WGM, gsz = (nM - fm) < WGM ? (nM - fm) : WGM;
        u.pm = fm + ((wgid % nig) % gsz); u.pn = (wgid % nig) / gsz; return true;
    }
    __device__ __forceinline__ void a_ready(const Unit&) const {}
    __device__ __forceinline__ void done(const Unit&) const {}
};


__device__ __forceinline__ unsigned cvt_pk_bf16(float lo, float hi) { unsigned r; asm volatile("v_cvt_pk_bf16_f32 %0, %1, %2" : "=v"(r) : "v"(lo), "v"(hi)); return r; }

struct EpiStore {
    static constexpr bool PERM = true, AFTER_DRAIN = false;
    bf16_t* O; int ldc; int pn_f32; float* F32; int ld32; int ncol32;
    __device__ __forceinline__ void operator()(const f32x4 (&acc)[2][2][4][2], const Unit& u, int wr, int wc, int fr, int fq) const {
        const int row0 = u.pm * BM + wr * 64 + fr;
        if (u.pn >= pn_f32) {
#pragma unroll
            for (int ai = 0; ai < 2; ++ai)
#pragma unroll
                for (int m = 0; m < 4; ++m) { const size_t row = (size_t)(row0 + ai * HALF + m * 16);
#pragma unroll
                    for (int bj = 0; bj < 2; ++bj)
#pragma unroll
                        for (int n = 0; n < 2; ++n) { const int c0 = bj * HALF + wc * 32 + 8 * fq + 4 * n;
#pragma unroll
                            for (int j = 0; j < 4; ++j) if (c0 + j < ncol32) F32[row * ld32 + c0 + j] = acc[ai][bj][m][n][j]; } }
            return;
        }
        const int col0 = u.pn * BM + wc * 32 + 8 * fq;
#pragma unroll
        for (int ai = 0; ai < 2; ++ai)
#pragma unroll
            for (int m = 0; m < 4; ++m) { bf16_t* rowp = O + (size_t)(row0 + ai * HALF + m * 16) * ldc + col0;
#pragma unroll
                for (int bj = 0; bj < 2; ++bj) { const f32x4 v0 = acc[ai][bj][m][0], v1 = acc[ai][bj][m][1];
                    u32x4 w; w.x = cvt_pk_bf16(v0[0], v0[1]); w.y = cvt_pk_bf16(v0[2], v0[3]); w.z = cvt_pk_bf16(v1[0], v1[1]); w.w = cvt_pk_bf16(v1[2], v1[3]);
                    *(u32x4*)(rowp + bj * HALF) = w; } }
    }
};

struct EpiResid {
    static constexpr bool PERM = false, AFTER_DRAIN = false;
    const float* xin; float* out; const float* gate;
    __device__ __forceinline__ void operator()(const f32x4 (&acc)[2][2][4][2], const Unit& u, int wr, int wc, int fr, int fq) const {
        const int col0 = u.pn * BM + wc * 32 + 4 * fq;
#pragma unroll
        for (int ai = 0; ai < 2; ++ai)
#pragma unroll
            for (int m = 0; m < 4; ++m) { const int row = u.pm * BM + ai * HALF + wr * 64 + m * 16 + fr; const int b = row >> 12; const size_t off = (size_t)row * 1024 + col0;
#pragma unroll
                for (int bj = 0; bj < 2; ++bj)
#pragma unroll
                    for (int n = 0; n < 2; ++n) { const int cc = bj * HALF + n * 16;
                        const f32x4 g = *(const f32x4*)(gate + (size_t)b * 6144 + col0 + cc); const f32x4 x = *(const f32x4*)(xin + off + cc);
                        *(f32x4*)(out + off + cc) = x + g * acc[ai][bj][m][n]; } }
    }
};
template <class Epi, class Sched, bool ALIGN_EPI = false, bool SP2 = false>
__device__ __forceinline__ void gemm_phase(PG8_LAS unsigned char* lds, const Gemm g, const Sched& S, const Epi& E) {
    const int tid = threadIdx.x, wid = __builtin_amdgcn_readfirstlane(tid >> 6), lane = tid & 63, wr = wid >> 2, wc = wid & 3, fr = lane & 15, fq = lane >> 4;
    const int K = g.K, nt = K / BK;
    unsigned voffA[2], voffB[2];
#pragma unroll
    for (int i = 0; i < 2; ++i) { int R, C; stage_rc(tid * 16 + i * 8192, R, C); const int Rb = Epi::PERM ? ((R & ~31) + perm32(R & 31)) : R;
        voffA[i] = (unsigned)(R * K + C) * 2u; voffB[i] = (unsigned)(Rb * K + C) * 2u; }
    const size_t kstep = (size_t)(BK * 2);
    const size_t hstep = (size_t)HALF * K * 2;
    const size_t tstep = 2 * hstep;
    const unsigned ldsw = (unsigned)wid * 1024u;
    const int aoff = lds_byte(wr * 64 + fr, fq * 8), boff = lds_byte(wc * 32 + fr, fq * 8);
#define PG8_SA(b, h) (((b) * 2 + (h)) * HTB)
#define PG8_SB(b, h) ((4 + (b) * 2 + (h)) * HTB)
#define PG8_STAGE(bufoff, gbase, voff) do { _Pragma("unroll") for (int _i = 0; _i < 2; ++_i) \
        __builtin_amdgcn_global_load_lds((const unsigned*)((const char*)(gbase) + (voff)[_i]), (PG8_LAS unsigned*)(lds + (bufoff) + ldsw + _i * 8192), 16, 0, 0); } while (0)
#define PG8_LDA(dst, b, h) do { _Pragma("unroll") for (int m = 0; m < 4; ++m) _Pragma("unroll") for (int k = 0; k < 2; ++k) dst[m][k] = *(const PG8_LAS bf16x8*)(lds + PG8_SA(b, h) + aoff + m * 2048 + k * 1024); } while (0)
#define PG8_LDB(dst, b, h) do { _Pragma("unroll") for (int n = 0; n < 2; ++n) _Pragma("unroll") for (int k = 0; k < 2; ++k) dst[n][k] = *(const PG8_LAS bf16x8*)(lds + PG8_SB(b, h) + boff + n * 2048 + k * 1024); } while (0)
#define PG8_MMA(ai, bj, At, Bt) do { __builtin_amdgcn_s_setprio(1); _Pragma("unroll") for (int m = 0; m < 4; ++m) _Pragma("unroll") for (int n = 0; n < 2; ++n) _Pragma("unroll") for (int k = 0; k < 2; ++k) \
        acc[ai][bj][m][n] = __builtin_amdgcn_mfma_f32_16x16x32_bf16(Bt[n][k], At[m][k], acc[ai][bj][m][n], 0, 0, 0); __builtin_amdgcn_s_setprio(0); } while (0)
#define PG8_WAIT_V(n) asm volatile("s_waitcnt vmcnt(" #n ")" ::: "memory")
#define PG8_WAIT_L(n) asm volatile("s_waitcnt lgkmcnt(" #n ")" ::: "memory")
#define PG8_BAR __builtin_amdgcn_s_barrier()
#define PG8_SCHED __builtin_amdgcn_sched_barrier(0)
    Unit cur, nxt; int ui = 0;
    if (!S.next(0, cur)) return;
    f32x4 acc[2][2][4][2];
#pragma unroll
    for (int a = 0; a < 2; ++a)
#pragma unroll
        for (int b = 0; b < 2; ++b)
#pragma unroll
            for (int m = 0; m < 4; ++m)
#pragma unroll
                for (int n = 0; n < 2; ++n) acc[a][b][m][n] = (f32x4){0.f, 0.f, 0.f, 0.f};
    bf16x8 At[4][2], B0[2][2], B1[2][2];
    const char* cA = (const char*)g.A + (size_t)cur.pm * tstep; const char* cB = (const char*)g.Bt + (size_t)cur.pn * tstep;
    S.a_ready(cur);
    if constexpr (SP2) {
        PG8_STAGE(PG8_SB(0, 0), cB, voffB); PG8_STAGE(PG8_SB(0, 1), cB + hstep, voffB); PG8_STAGE(PG8_SA(0, 0), cA, voffA); PG8_STAGE(PG8_SA(0, 1), cA + hstep, voffA);
        if (wr == 1) PG8_BAR;
        PG8_WAIT_V(2); PG8_BAR;
        PG8_STAGE(PG8_SB(1, 0), cB + kstep, voffB); PG8_STAGE(PG8_SA(1, 0), cA + kstep, voffA); PG8_STAGE(PG8_SB(1, 1), cB + hstep + kstep, voffB);
        PG8_WAIT_V(6); PG8_BAR;
    } else {
        PG8_STAGE(PG8_SB(0, 0), cB, voffB); PG8_STAGE(PG8_SA(0, 0), cA, voffA); PG8_STAGE(PG8_SB(0, 1), cB + hstep, voffB); PG8_STAGE(PG8_SA(0, 1), cA + hstep, voffA);
        if (wr == 1) PG8_BAR;
        PG8_WAIT_V(4); PG8_BAR;
        PG8_STAGE(PG8_SB(1, 0), cB + kstep, voffB); PG8_STAGE(PG8_SA(1, 0), cA + kstep, voffA); PG8_STAGE(PG8_SB(1, 1), cB + hstep + kstep, voffB);
        PG8_WAIT_V(6); PG8_BAR;
    }
    for (;;) {
        const bool has_next = S.next(ui + 1, nxt);
        const char* nA = has_next ? (const char*)g.A + (size_t)nxt.pm * tstep : cA; const char* nB = has_next ? (const char*)g.Bt + (size_t)nxt.pn * tstep : cB;
        for (int t = 0; t < nt; t += 2) {
            const bool last = (t == nt - 2);
            const char* a1 = cA + (size_t)(t + 1) * kstep;
            const char* a2 = last ? nA : cA + (size_t)(t + 2) * kstep; const char* b2 = last ? nB : cB + (size_t)(t + 2) * kstep;
            const char* a3 = a2 + kstep; const char* b3 = b2 + kstep;
            if (last && has_next) S.a_ready(nxt);
            if constexpr (SP2) {
            PG8_LDB(B0, 0, 0); PG8_LDB(B1, 0, 1); PG8_SCHED; PG8_LDA(At, 0, 0); PG8_STAGE(PG8_SA(1, 1), a1 + hstep, voffA);
            PG8_WAIT_V(8); PG8_WAIT_L(0); PG8_BAR; PG8_MMA(0, 0, At, B0); PG8_MMA(0, 1, At, B1); PG8_BAR; PG8_SCHED;
            PG8_LDA(At, 0, 1); PG8_STAGE(PG8_SB(0, 0), b2, voffB); PG8_STAGE(PG8_SB(0, 1), b2 + hstep, voffB); PG8_STAGE(PG8_SA(0, 0), a2, voffA);
            PG8_WAIT_V(8); PG8_WAIT_L(0); PG8_BAR; PG8_MMA(1, 0, At, B0); PG8_MMA(1, 1, At, B1); PG8_BAR; PG8_SCHED;
            PG8_LDB(B0, 1, 0); PG8_LDB(B1, 1, 1); PG8_SCHED; PG8_LDA(At, 1, 0); PG8_STAGE(PG8_SA(0, 1), a2 + hstep, voffA);
            PG8_WAIT_V(8); PG8_WAIT_L(0); PG8_BAR; PG8_MMA(0, 0, At, B0); PG8_MMA(0, 1, At, B1); PG8_BAR; PG8_SCHED;
            PG8_LDA(At, 1, 1); PG8_STAGE(PG8_SB(1, 0), b3, voffB); PG8_STAGE(PG8_SB(1, 1), b3 + hstep, voffB); PG8_STAGE(PG8_SA(1, 0), a3, voffA);
            PG8_WAIT_V(8); PG8_WAIT_L(0); PG8_BAR; PG8_MMA(1, 0, At, B0); PG8_MMA(1, 1, At, B1); PG8_BAR; PG8_SCHED;
            } else {
            PG8_LDB(B0, 0, 0); PG8_SCHED; PG8_LDA(At, 0, 0); PG8_STAGE(PG8_SA(1, 1), a1 + hstep, voffA);
            PG8_WAIT_L(8); PG8_BAR; PG8_WAIT_L(0); PG8_MMA(0, 0, At, B0); PG8_BAR; PG8_SCHED;
            PG8_LDB(B1, 0, 1); PG8_STAGE(PG8_SB(0, 0), b2, voffB);
            PG8_BAR; PG8_WAIT_L(0); PG8_MMA(0, 1, At, B1); PG8_BAR;
            PG8_LDA(At, 0, 1); PG8_STAGE(PG8_SA(0, 0), a2, voffA);
            PG8_BAR; PG8_WAIT_L(0); PG8_MMA(1, 0, At, B0); PG8_BAR; PG8_SCHED;
            PG8_STAGE(PG8_SB(0, 1), b2 + hstep, voffB);
            PG8_WAIT_V(6); PG8_BAR; PG8_MMA(1, 1, At, B1); PG8_BAR;
            PG8_LDB(B0, 1, 0); PG8_SCHED; PG8_LDA(At, 1, 0); PG8_STAGE(PG8_SA(0, 1), a2 + hstep, voffA);
            PG8_WAIT_L(8); PG8_BAR; PG8_WAIT_L(0); PG8_MMA(0, 0, At, B0); PG8_BAR; PG8_SCHED;
            PG8_LDB(B1, 1, 1); PG8_STAGE(PG8_SB(1, 0), b3, voffB);
            PG8_BAR; PG8_WAIT_L(0); PG8_MMA(0, 1, At, B1); PG8_BAR;
            PG8_LDA(At, 1, 1); PG8_STAGE(PG8_SA(1, 0), a3, voffA);
            PG8_BAR; PG8_WAIT_L(0); PG8_MMA(1, 0, At, B0); PG8_BAR; PG8_SCHED;
            PG8_STAGE(PG8_SB(1, 1), b3 + hstep, voffB);
            PG8_WAIT_V(6); PG8_BAR; PG8_MMA(1, 1, At, B1); PG8_BAR;
            }
        }
        if constexpr (ALIGN_EPI) { if (wr == 0) PG8_BAR; }
        if constexpr (!Epi::AFTER_DRAIN) { E(acc, cur, wr, wc, fr, fq); S.done(cur); }
        if (!has_next) break;
#pragma unroll
        for (int a = 0; a < 2; ++a)
#pragma unroll
            for (int b = 0; b < 2; ++b)
#pragma unroll
                for (int m = 0; m < 4; ++m)
#pragma unroll
                    for (int n = 0; n < 2; ++n) acc[a][b][m][n] = (f32x4){0.f, 0.f, 0.f, 0.f};
        cur = nxt; cA = nA; cB = nB; ++ui;
        if constexpr (ALIGN_EPI) { if (wr == 1) PG8_BAR; }
    }
    PG8_WAIT_V(0);
    if constexpr (!ALIGN_EPI) { if (wr == 0) PG8_BAR; }
    PG8_BAR;
    if constexpr (Epi::AFTER_DRAIN) { E.fused(acc, cur, wr, wc, fr, fq, lds, wid, lane); S.done(cur); }
#undef PG8_SA
#undef PG8_SB
#undef PG8_STAGE
#undef PG8_LDA
#undef PG8_LDB
#undef PG8_MMA
#undef PG8_WAIT_V
#undef PG8_WAIT_L
#undef PG8_BAR
#undef PG8_SCHED
}
}
#define GAS __attribute__((address_space(1)))
#define LAS __attribute__((address_space(3)))
typedef unsigned short bf16;
typedef unsigned v4u __attribute__((ext_vector_type(4)));
typedef float f32x4 __attribute__((ext_vector_type(4)));
typedef short bf16x8 __attribute__((ext_vector_type(8)));
typedef GAS unsigned gu32;
typedef GAS unsigned long long gu64;
#define RLX_AGENT __ATOMIC_RELAXED, __HIP_MEMORY_SCOPE_AGENT
#define LDS_WAIT() asm volatile("s_waitcnt lgkmcnt(0)" ::: "memory")
#define VM_WAIT() asm volatile("s_waitcnt vmcnt(0)" ::: "memory")
__device__ __forceinline__ unsigned long long rt() { return __builtin_amdgcn_s_memrealtime(); }
__device__ __forceinline__ unsigned f2bf(float f) { unsigned u = __builtin_bit_cast(unsigned, f); return (u + 0x7fffu + ((u >> 16) & 1u)) >> 16; }
__device__ __forceinline__ unsigned pk2(float lo, float hi) { return f2bf(lo) | (f2bf(hi) << 16); }

#define XB_TMO      128
#define XB_XCNT(j)  (256  + 64 * (j))
#define XB_XSUB(j)  (1280 + 64 * (j))
#define XB_XGEN(j)  (2304 + 64 * (j))
#define XB_TOP      3328
#define XB_TOPGEN   3392
#define XCD_BAR_WORDS 3456
#define XB_SPIN_CAP (1u << 18)

__device__ __forceinline__ unsigned xb_ld(unsigned* p)              { return __hip_atomic_load(p, __ATOMIC_RELAXED, __HIP_MEMORY_SCOPE_AGENT); }
__device__ __forceinline__ unsigned xb_add(unsigned* p, unsigned v) { return __hip_atomic_fetch_add(p, v, __ATOMIC_RELAXED, __HIP_MEMORY_SCOPE_AGENT); }
__device__ __forceinline__ unsigned xb_xcc_id() { return (unsigned)__builtin_amdgcn_s_getreg((3 << 11) | 20) & 0xFu; }
#define XB_SPIN(cond, bar) do { unsigned _sp = 0; while (cond) { __builtin_amdgcn_s_sleep(1); \
    if ((++_sp & 255u) == 0u) { if (xb_ld(&(bar)[XB_TMO])) break; if (_sp > XB_SPIN_CAP) { atomicAdd(&(bar)[XB_TMO], 1u); break; } } } } while (0)

struct XcdBarrier {
    unsigned* bar; unsigned x;
    volatile LAS unsigned* st;
};

__device__ __forceinline__ XcdBarrier xcd_barrier_post(unsigned* bar, volatile LAS unsigned* st) {
    XcdBarrier b; b.bar = bar; b.x = xb_xcc_id(); b.st = st;
    if (threadIdx.x == 0) (void)xb_add(&bar[XB_XCNT(b.x)], 1u);
    return b;
}
__device__ __forceinline__ void xcd_barrier_complete(unsigned* bar, unsigned x, unsigned& nloc, unsigned& nx) {
    const unsigned G = gridDim.x * gridDim.y * gridDim.z;
    unsigned sum, cnt, mine, sp = 0u;
    for (;;) {
        sum = 0u; cnt = 0u; mine = 0u;
#pragma unroll
        for (unsigned j = 0; j < 16; ++j) { const unsigned c = xb_ld(&bar[XB_XCNT(j)]); sum += c; cnt += (c > 0u) ? 1u : 0u; mine = (j == x) ? c : mine; }
        if (sum == G) break;
        __builtin_amdgcn_s_sleep(1);
        if ((++sp & 255u) == 0u) { if (xb_ld(&bar[XB_TMO])) break; if (sp > XB_SPIN_CAP) { atomicAdd(&bar[XB_TMO], 1u); break; } }
    }
    nloc = mine > 0u ? mine : 1u; nx = cnt > 0u ? cnt : 1u;
}

__device__ __forceinline__ void xcd_barrier(const XcdBarrier& b) {
    asm volatile("s_waitcnt vmcnt(0)" ::: "memory");
    __syncthreads();
    if (threadIdx.x == 0) {
        unsigned* bar = b.bar;
        __builtin_amdgcn_s_waitcnt(0);
        unsigned nloc = b.st[0], nx = b.st[1];
        if (nloc == 0u) { xcd_barrier_complete(bar, b.x, nloc, nx); b.st[0] = nloc; b.st[1] = nx; }
        const unsigned old = xb_add(&bar[XB_XSUB(b.x)], 1u);
        const unsigned gen = old / nloc;
        if (old + 1u == (gen + 1u) * nloc) {
            __builtin_amdgcn_fence(__ATOMIC_RELEASE, "agent");
            asm volatile("s_waitcnt vmcnt(0)" ::: "memory");
            const unsigned og = xb_add(&bar[XB_TOP], 1u);
            const unsigned tg = og / nx;
            if (og + 1u == (tg + 1u) * nx) xb_add(&bar[XB_TOPGEN], 1u);
            else XB_SPIN(xb_ld(&bar[XB_TOPGEN]) == tg, bar);
            __builtin_amdgcn_fence(__ATOMIC_ACQUIRE, "agent");
            xb_add(&bar[XB_XGEN(b.x)], 1u);
            asm volatile("s_waitcnt vmcnt(0)" ::: "memory");
        } else {
            XB_SPIN(xb_ld(&bar[XB_XGEN(b.x)]) == gen, bar);
            __builtin_amdgcn_fence(__ATOMIC_ACQUIRE, "agent");
            asm volatile("s_waitcnt vmcnt(0)" ::: "memory");
        }
    }
    __syncthreads();
}

constexpr int NWAVES = 8, NT = 512;
constexpr int BATCH = 4, SEQ = 4096, DM = 1024, M = BATCH * SEQ;
constexpr int NPROJ = 3088, NPROJ_PAD = 3328, PROJ_LD = 3072, NMIX = 1536, NQ = 2048;
constexpr int NBC = M / 128;
constexpr float EPS = 1e-6f;
typedef float f32x16 __attribute__((ext_vector_type(16)));
typedef unsigned v2u __attribute__((ext_vector_type(2)));

constexpr size_t MiB = 1u << 20;
constexpr size_t WS_CTL = 0, CTL_ZERO_BYTES = 64 * 1024;
constexpr size_t WS_MOD = 1 * MiB, WS_KEYS = 2 * MiB, WS_CD = 3 * MiB;
constexpr size_t WS_WIN = 4 * MiB, WS_WOUT = 17 * MiB, WS_WQ = 23 * MiB;
constexpr size_t WS_ED = 32 * MiB, WS_EU = 96 * MiB;
constexpr size_t WS_XN = 160 * MiB;
constexpr size_t WS_PROJ = 208 * MiB;
constexpr size_t WS_ST = 304 * MiB;
constexpr size_t WS_X2 = 336 * MiB;
constexpr size_t WS_CBC = 400 * MiB;
constexpr size_t WS_XBT = 416 * MiB;
constexpr size_t WS_WF = 456 * MiB;
constexpr size_t WS_DTRAW = 460 * MiB, WS_DTV = 461 * MiB, WS_ACS = 462 * MiB, WS_SSQ = 463 * MiB;
constexpr size_t WS_IDX = 464 * MiB, WS_GATE = 472 * MiB;
constexpr size_t WS_END = 480 * MiB;
constexpr int CW_BAR = 1024;
static_assert((CW_BAR + XCD_BAR_WORDS) * 4 <= (int)CTL_ZERO_BYTES, "ctl");

constexpr int RING_BYTES = 131072, LDSCTL_OFF = RING_BYTES, MISC_OFF = LDSCTL_OFF + 320, LDS_BYTES = 147456;

__device__ __forceinline__ float bflo(unsigned w) { return __uint_as_float(w << 16); }
__device__ __forceinline__ float bfhi(unsigned w) { return __uint_as_float(w & 0xffff0000u); }
__device__ __forceinline__ float bf2f(unsigned short h) { return __uint_as_float(((unsigned)h) << 16); }
__device__ __forceinline__ float siluf(float x) { return x / (1.f + __expf(-x)); }
__device__ __forceinline__ float wave_sum(float v) {
#pragma unroll
    for (int o = 1; o < 64; o <<= 1) v += __shfl_xor(v, o);
    return v;
}
__device__ __forceinline__ int rowoff(int reg, int h) { return (reg & 3) + 8 * (reg >> 2) + 4 * h; }
#define MFMA32(a, b, c) __builtin_amdgcn_mfma_f32_32x32x16_bf16((a), (b), (c), 0, 0, 0)

struct Ctx { LAS unsigned char* lds; int tid, lane, wave, G, bid; };
__device__ __forceinline__ Ctx fresh(const Ctx& X) { Ctx Y; Y.lds = X.lds; int t = X.tid; asm volatile("" : "+v"(t)); int g = X.G, b = X.bid; asm volatile("" : "+s"(g), "+s"(b)); Y.tid = t; Y.lane = t & 63; Y.wave = __builtin_amdgcn_readfirstlane(t >> 6); Y.G = g; Y.bid = b; return Y; }

__device__ __forceinline__ void p0_mod(const Ctx& X, const float* c, const float* w_ada, const float* b_ada, float* MOD) {
    LAS float* cs = (LAS float*)X.lds; LAS float* red = (LAS float*)(X.lds + 16384);
    for (int i = X.tid; i < 4096; i += NT) cs[i] = siluf(c[i]);
    __syncthreads();
    for (int item = X.bid; item < 192; item += X.G) {
        const int l = item / 96, cc = item % 96, col = cc * 64 + X.lane;
        const float* W = w_ada + (size_t)l * 1024 * 6144 + col;
        float a0 = 0.f, a1 = 0.f, a2 = 0.f, a3 = 0.f;
#pragma unroll 8
        for (int kk = 0; kk < 128; ++kk) { const int k = X.wave * 128 + kk; const float w = W[(size_t)k * 6144];
            a0 += cs[k] * w; a1 += cs[1024 + k] * w; a2 += cs[2048 + k] * w; a3 += cs[3072 + k] * w; }
        red[(X.wave * 4 + 0) * 64 + X.lane] = a0; red[(X.wave * 4 + 1) * 64 + X.lane] = a1; red[(X.wave * 4 + 2) * 64 + X.lane] = a2; red[(X.wave * 4 + 3) * 64 + X.lane] = a3;
        __syncthreads();
        if (X.tid < 256) { const int b = X.tid >> 6, ln = X.tid & 63; float s = 0.f;
#pragma unroll
            for (int w = 0; w < 8; ++w) s += red[(w * 4 + b) * 64 + ln];
            MOD[((size_t)l * 4 + b) * 6144 + cc * 64 + ln] = s + b_ada[(size_t)l * 6144 + cc * 64 + ln]; }
        __syncthreads();
    }
}
__device__ __forceinline__ void p0_fold(const Ctx& X, const float* w_in, const float* pool_w, float* WF) {
    const int gt = X.bid * NT + X.tid, GT = X.G * NT;
    for (int o = gt; o < 2 * 1024 * 512; o += GT) {
        const int n = o & 511, k = (o >> 9) & 1023, l = o >> 19, g = n >> 7, d = n & 127;
        const float* wi = w_in + ((size_t)l * 1024 + k) * NPROJ + g * 128;
        const float* pw = pool_w + ((size_t)(l * 4 + g) * 128) * 128 + d;
        float s = 0.f;
#pragma unroll 8
        for (int c = 0; c < 128; ++c) s += wi[c] * pw[(size_t)c * 128];
        WF[o] = s;
    }
}
__device__ __forceinline__ void p0_cvt(const Ctx& X, const float* src, bf16* dst, size_t n8) {
    const size_t gt = (size_t)X.bid * NT + X.tid, GT = (size_t)X.G * NT;
    for (size_t i = gt; i < n8; i += GT) {
        const f32x4 a = ((const f32x4*)src)[2 * i], b = ((const f32x4*)src)[2 * i + 1];
        v4u o; o.x = pk2(a.x, a.y); o.y = pk2(a.z, a.w); o.z = pk2(b.x, b.y); o.w = pk2(b.z, b.w);
        ((v4u*)dst)[i] = o;
    }
}
__device__ __forceinline__ void tr_item(const float* W, int ldw, int nvalid, int K, bf16* WT, LAS float* scr, int kb, int n_src0, int n_dst0, int lane) {
    const int k0 = 64 * kb;
#pragma unroll 8
    for (int i = 0; i < 32; ++i) { const int kk = 2 * i + (lane >> 5); const int n = n_src0 + (lane & 31);
        scr[kk * 33 + (lane & 31)] = (n < nvalid) ? W[(size_t)(k0 + kk) * ldw + n] : 0.f; }
    LDS_WAIT(); asm volatile("" ::: "memory");
    const int c = lane & 7;
#pragma unroll
    for (int j = 0; j < 4; ++j) { const int n = (lane >> 3) + 8 * j; const LAS float* s = scr + (8 * c) * 33 + n;
        v4u o; o.x = pk2(s[0 * 33], s[1 * 33]); o.y = pk2(s[2 * 33], s[3 * 33]); o.z = pk2(s[4 * 33], s[5 * 33]); o.w = pk2(s[6 * 33], s[7 * 33]);
        *(v4u*)(WT + (size_t)(n_dst0 + n) * K + k0 + 8 * c) = o; }
    LDS_WAIT(); asm volatile("" ::: "memory");
}
__device__ __forceinline__ void p0_transposes(const Ctx& X, const float* w_in, const float* WF, const float* w_out, const float* w_query, bf16* WIN, bf16* WOUT, bf16* WQ) {
    LAS float* scr = (LAS float*)(X.lds + X.wave * 16384);
    const int gw = X.bid * NWAVES + X.wave, NGW = X.G * NWAVES;
    constexpr int I_IN = 16 * 104, I_OUT = 24 * 32, I_Q = 16 * 64, I_L = I_IN + I_OUT + I_Q;
    for (int it = gw; it < 2 * I_L; it += NGW) {
        const int l = it / I_L; int r = it % I_L;
        if (r < I_IN) { const int kb = r / 104, nb = r % 104;
            if (nb < 16) tr_item(WF + (size_t)l * 1024 * 512, 512, 512, 1024, WIN + (size_t)l * NPROJ_PAD * 1024, scr, kb, nb * 32, nb * 32, X.lane);
            else tr_item(w_in + (size_t)l * 1024 * NPROJ, NPROJ, NPROJ, 1024, WIN + (size_t)l * NPROJ_PAD * 1024, scr, kb, nb * 32, nb * 32, X.lane);
            continue; }
        r -= I_IN;
        if (r < I_OUT) { const int kb = r / 32, nb = r % 32; tr_item(w_out + (size_t)l * NMIX * 1024, 1024, 1024, NMIX, WOUT + (size_t)l * 1024 * NMIX, scr, kb, nb * 32, nb * 32, X.lane); continue; }
        r -= I_OUT;
        { const int kb = r / 64, nb = r % 64; tr_item(w_query + (size_t)l * 1024 * NQ, NQ, NQ, 1024, WQ + (size_t)l * NQ * 1024, scr, kb, nb * 32, nb * 32, X.lane); }
    }
}
__device__ __forceinline__ void norm_mod_phase(const Ctx& X, const float* xin, const float* g, const float* shift, const float* scale, bf16* XN) {
    const int gw = X.bid * NWAVES + X.wave, NGW = X.G * NWAVES;
    for (int m = gw; m < M; m += NGW) {
        const int b = m >> 12;
        const f32x4* xr = (const f32x4*)(xin + (size_t)m * DM) + X.lane;
        f32x4 v[4]; float s = 0.f;
#pragma unroll
        for (int j = 0; j < 4; ++j) { v[j] = xr[64 * j]; s += (v[j].x * v[j].x + v[j].y * v[j].y) + (v[j].z * v[j].z + v[j].w * v[j].w); }
        const float rstd = 1.0f / sqrtf(wave_sum(s) * (1.f / DM) + EPS);
        unsigned long long* o8 = (unsigned long long*)(XN + (size_t)m * DM) + X.lane;
#pragma unroll
        for (int j = 0; j < 4; ++j) { const int col = 256 * j + 4 * X.lane;
            const f32x4 gv = *(const f32x4*)(g + col), sc = *(const f32x4*)(scale + (size_t)b * 6144 + col), sh = *(const f32x4*)(shift + (size_t)b * 6144 + col);
            const f32x4 o = (v[j] * rstd) * gv * (sc + 1.0f) + sh;
            o8[64 * j] = (unsigned long long)pk2(o.x, o.y) | ((unsigned long long)pk2(o.z, o.w) << 32); }
    }
}
__device__ __forceinline__ void conv_phase(const Ctx& X, const bf16* PROJ, const float* conv_w, const float* conv_b, bf16* CBC, bf16* XBT) {
    LAS unsigned char* raw = X.lds;
    for (int u = X.bid; u < NBC * 6; u += X.G) {
        const int bc = u / 6, slab = u % 6, c = bc & 31, t0 = bc * 128;
        for (int i = X.tid; i < 131 * 128; i += NT) { const int r = i >> 7, cp = i & 127; const int pos = c * 128 + r - 3;
            unsigned val = 0u; if (pos >= 0) val = *(const unsigned*)(PROJ + (size_t)(t0 + r - 3) * PROJ_LD + 1536 + slab * 256 + 2 * cp);
            *(LAS unsigned*)(raw + r * 516 + cp * 4) = val; }
        __syncthreads();
        if (slab >= 4) {
            const int cp = X.tid & 127, lr = X.tid >> 7, chx = slab * 256 + 2 * cp;
            float w0[4], w1[4];
#pragma unroll
            for (int j = 0; j < 4; ++j) { w0[j] = conv_w[j * 1536 + chx]; w1[j] = conv_w[j * 1536 + chx + 1]; }
            const float b0 = conv_b[chx], b1 = conv_b[chx + 1];
            for (int l = 32 * lr; l < 32 * lr + 32; ++l) { float a0 = b0, a1 = b1;
#pragma unroll
                for (int j = 0; j < 4; ++j) { const unsigned w = *(LAS unsigned*)(raw + (l + j) * 516 + cp * 4); a0 += w0[j] * bflo(w); a1 += w1[j] * bfhi(w); }
                *(unsigned*)(CBC + (size_t)(t0 + l) * 512 + (slab - 4) * 256 + 2 * cp) = pk2(siluf(a0), siluf(a1)); }
        }
        if (slab <= 4) {
            const int l = X.tid & 127, cr = X.tid >> 7;
            for (int ci = 0; ci < 64; ++ci) { const int ch = cr * 64 + ci, chx = slab * 256 + ch;
                float a = conv_b[chx];
#pragma unroll
                for (int j = 0; j < 4; ++j) a += conv_w[j * 1536 + chx] * bf2f(*(LAS unsigned short*)(raw + (l + j) * 516 + ch * 2));
                XBT[((size_t)bc * 1280 + chx) * 128 + l] = (bf16)f2bf(siluf(a)); }
        }
        __syncthreads();
    }
}
__device__ __forceinline__ void ssd_states_phase(const Ctx& X, const float* DTRAW, const float* dt_bias, const float* a_log, const bf16* XBT, float* DTV, float* ACS, float* CD, bf16* ST) {
    LAS float* dts = (LAS float*)X.lds; LAS float* as_ = dts + 128; LAS float* acsL = dts + 256; LAS float* wl = dts + 384;
    const int r = X.lane & 31, h = X.lane >> 5;
    for (int u = X.bid; u < NBC * 16; u += X.G) {
        const int bc = u >> 4, hh = u & 15, g = hh >> 3, t0 = bc * 128;
        if (X.tid < 128) { const float x = DTRAW[(size_t)(t0 + X.tid) * 16 + hh] + dt_bias[hh]; const float dt = x > 20.f ? x : log1pf(__expf(x));
            dts[X.tid] = dt; as_[X.tid] = -dt * __expf(a_log[hh]); }
        __syncthreads();
        if (X.tid < 128) { float s = 0.f; for (int j = 0; j <= X.tid; ++j) s += as_[j]; acsL[X.tid] = s; }
        __syncthreads();
        if (X.tid < 128) { const float tot = acsL[127], a = acsL[X.tid]; wl[X.tid] = __expf(tot - a) * dts[X.tid];
            DTV[(size_t)(t0 + X.tid) * 16 + hh] = dts[X.tid]; ACS[(size_t)(t0 + X.tid) * 16 + hh] = a; if (X.tid == 0) CD[bc * 16 + hh] = __expf(tot); }
        __syncthreads();
        const int pb = X.wave & 1, nb = X.wave >> 1;
        const bf16* xrow = XBT + ((size_t)bc * 1280 + hh * 64 + 32 * pb + r) * 128;
        const bf16* brow = XBT + ((size_t)bc * 1280 + 1024 + g * 128 + 32 * nb + r) * 128;
        f32x16 acc;
#pragma unroll
        for (int i = 0; i < 16; ++i) acc[i] = 0.f;
#pragma unroll
        for (int ks = 0; ks < 8; ++ks) { const int k0 = 16 * ks + 8 * h;
            const v4u xa = *(const v4u*)(xrow + k0); const bf16x8 bb = *(const bf16x8*)(brow + k0);
            v4u sa; sa.x = pk2(bflo(xa.x) * wl[k0 + 0], bfhi(xa.x) * wl[k0 + 1]); sa.y = pk2(bflo(xa.y) * wl[k0 + 2], bfhi(xa.y) * wl[k0 + 3]);
            sa.z = pk2(bflo(xa.z) * wl[k0 + 4], bfhi(xa.z) * wl[k0 + 5]); sa.w = pk2(bflo(xa.w) * wl[k0 + 6], bfhi(xa.w) * wl[k0 + 7]);
            acc = MFMA32(__builtin_bit_cast(bf16x8, sa), bb, acc); }
        bf16* so = ST + ((size_t)(bc * 16 + hh) * 64) * 128;
#pragma unroll
        for (int i = 0; i < 16; ++i) { const int p = 32 * pb + rowoff(i, h); so[(size_t)p * 128 + 32 * nb + r] = (bf16)f2bf(acc[i]); }
        __syncthreads();
    }
}
__device__ __forceinline__ void ssd_scan_phase(const Ctx& X, bf16* ST, const float* CD) {
    const int gt = X.bid * NT + X.tid, GT = X.G * NT;
    for (int e = gt; e < 131072; e += GT) {
        const int n4 = e & 31, p = (e >> 5) & 63, hh = (e >> 11) & 15, b = e >> 15;
        bf16* base = ST + ((size_t)((b * 32) * 16 + hh) * 64 + p) * 128 + n4 * 4;
        v2u st[32];
#pragma unroll
        for (int c = 0; c < 32; ++c) st[c] = *(const v2u*)(base + (size_t)c * 131072);
        float h0 = 0.f, h1 = 0.f, h2 = 0.f, h3 = 0.f;
#pragma unroll
        for (int c = 0; c < 32; ++c) { const float cd = CD[(b * 32 + c) * 16 + hh];
            v2u o; o.x = pk2(h0, h1); o.y = pk2(h2, h3); *(v2u*)(base + (size_t)c * 131072) = o;
            h0 = h0 * cd + bflo(st[c].x); h1 = h1 * cd + bfhi(st[c].x); h2 = h2 * cd + bflo(st[c].y); h3 = h3 * cd + bfhi(st[c].y); }
    }
}
__device__ __forceinline__ void ssd_out_phase(const Ctx& X, const bf16* CBC, const bf16* XBT, const bf16* ST, const float* DTV, const float* ACS, const float* d_skip, const bf16* PROJ, bf16* YA, float* SSQ) {
    LAS bf16* Ml = (LAS bf16*)X.lds;
    LAS float* acsL = (LAS float*)(X.lds + 34816); LAS float* dtL = acsL + 128; LAS float* eaL = acsL + 256; LAS float* ssqL = acsL + 384;
    const int r = X.lane & 31, h = X.lane >> 5;
    for (int u = X.bid; u < NBC * 16; u += X.G) {
        const int bc = u >> 4, hh = u & 15, g = hh >> 3, t0 = bc * 128;
        if (X.tid < 128) { const float a = ACS[(size_t)(t0 + X.tid) * 16 + hh]; acsL[X.tid] = a; dtL[X.tid] = DTV[(size_t)(t0 + X.tid) * 16 + hh]; eaL[X.tid] = __expf(a); }
        __syncthreads();
        {
            const int lb = X.wave >> 1, sh = X.wave & 1;
            for (int sb = 2 * sh; sb < 2 * sh + 2; ++sb) {
                if (sb > lb) continue;
                const bf16* crow = CBC + (size_t)(t0 + 32 * lb + r) * 512 + 256 + g * 128;
                const bf16* brow = CBC + (size_t)(t0 + 32 * sb + r) * 512 + g * 128;
                f32x16 acc;
#pragma unroll
                for (int i = 0; i < 16; ++i) acc[i] = 0.f;
#pragma unroll
                for (int ks = 0; ks < 8; ++ks) { const int k0 = 16 * ks + 8 * h; acc = MFMA32(*(const bf16x8*)(crow + k0), *(const bf16x8*)(brow + k0), acc); }
                const int s = 32 * sb + r; const float as = acsL[s], ds = dtL[s];
#pragma unroll
                for (int i = 0; i < 16; ++i) { const int l = 32 * lb + rowoff(i, h); const float vv = acc[i] * __expf(acsL[l] - as) * ds; const unsigned msk = (unsigned)((l - s) >> 31); Ml[l * 136 + s] = (bf16)f2bf(__uint_as_float(__float_as_uint(vv) & ~msk)); }
            }
        }
        __syncthreads();
        {
            const int lb = X.wave >> 1, pb = X.wave & 1;
            const bf16* xrow = XBT + ((size_t)bc * 1280 + hh * 64 + 32 * pb + r) * 128;
            f32x16 accd, acco;
#pragma unroll
            for (int i = 0; i < 16; ++i) { accd[i] = 0.f; acco[i] = 0.f; }
            for (int ks = 0; ks < 2 * (lb + 1); ++ks) { const int k0 = 16 * ks + 8 * h;
                accd = MFMA32(*(const LAS bf16x8*)(Ml + (32 * lb + r) * 136 + k0), *(const bf16x8*)(xrow + k0), accd); }
            const bf16* crow = CBC + (size_t)(t0 + 32 * lb + r) * 512 + 256 + g * 128;
            const bf16* hrow = ST + ((size_t)(bc * 16 + hh) * 64 + 32 * pb + r) * 128;
#pragma unroll
            for (int ks = 0; ks < 8; ++ks) { const int k0 = 16 * ks + 8 * h; acco = MFMA32(*(const bf16x8*)(crow + k0), *(const bf16x8*)(hrow + k0), acco); }
            const float dsk = d_skip[hh]; const int p = 32 * pb + r;
#pragma unroll
            for (int i = 0; i < 16; ++i) { const int l = 32 * lb + rowoff(i, h);
                float y = accd[i] + eaL[l] * acco[i];
                y += dsk * bf2f(xrow[l]);
                const float z = bf2f(PROJ[(size_t)(t0 + l) * PROJ_LD + 512 + hh * 64 + p]);
                const float yg = y * siluf(z);
                YA[(size_t)(t0 + l) * NMIX + 512 + hh * 64 + p] = (bf16)f2bf(yg);
                float q = yg * yg;
                q += __shfl_xor(q, 1); q += __shfl_xor(q, 2); q += __shfl_xor(q, 4); q += __shfl_xor(q, 8); q += __shfl_xor(q, 16);
                if (r == 0) ssqL[l * 2 + pb] = q; }
        }
        __syncthreads();
        if (X.tid < 128) SSQ[(size_t)(t0 + X.tid) * 16 + hh] = ssqL[X.tid * 2] + ssqL[X.tid * 2 + 1];
        __syncthreads();
    }
}
__device__ __forceinline__ void mix_finish_phase(const Ctx& X, const bf16* PROJ, const float* SSQ, const float* ssd_norm, const float* pool_b, const float* pool_scale, bf16* YA) {
    for (int rb = X.bid; rb < M / 64; rb += X.G) {
        for (int i = 0; i < 8; ++i) {
            const int t = rb * 64 + X.wave * 8 + i, pos = t & 4095;
            float q = (X.lane < 16) ? SSQ[(size_t)t * 16 + X.lane] : 0.f; q = wave_sum(q);
            const float rstd = 1.0f / sqrtf(q * (1.f / 1024.f) + EPS);
#pragma unroll
            for (int hf = 0; hf < 2; ++hf) { const int ch = hf * 512 + 8 * X.lane; bf16* yp = YA + (size_t)t * NMIX + 512 + ch;
                const v4u v = *(const v4u*)yp; const f32x4 g0 = *(const f32x4*)(ssd_norm + ch), g1 = *(const f32x4*)(ssd_norm + ch + 4);
                v4u o; o.x = pk2(bflo(v.x) * rstd * g0.x, bfhi(v.x) * rstd * g0.y); o.y = pk2(bflo(v.y) * rstd * g0.z, bfhi(v.y) * rstd * g0.w);
                o.z = pk2(bflo(v.z) * rstd * g1.x, bfhi(v.z) * rstd * g1.y); o.w = pk2(bflo(v.w) * rstd * g1.z, bfhi(v.w) * rstd * g1.w);
                *(v4u*)yp = o; }
            {
                const int ch = 8 * X.lane, w = 2 << (X.lane >> 4);
                float s[8], cur[8];
#pragma unroll
                for (int e = 0; e < 8; ++e) { s[e] = 0.f; cur[e] = 0.f; }
                for (int j = 0; j < 16; ++j) {
                    if (j < w && j <= pos) { const v4u v = *(const v4u*)(PROJ + (size_t)(t - j) * PROJ_LD + ch);
                        const float f[8] = {bflo(v.x), bfhi(v.x), bflo(v.y), bfhi(v.y), bflo(v.z), bfhi(v.z), bflo(v.w), bfhi(v.w)};
#pragma unroll
                        for (int e = 0; e < 8; ++e) { s[e] += f[e]; if (j == 0) cur[e] = f[e]; } }
                }
                const float inv = 1.0f / (float)((pos + 1 < w) ? (pos + 1) : w);
                const f32x4 b0 = *(const f32x4*)(pool_b + ch), b1 = *(const f32x4*)(pool_b + ch + 4), c0 = *(const f32x4*)(pool_scale + ch), c1 = *(const f32x4*)(pool_scale + ch + 4);
                float o[8];
                o[0] = (s[0] * inv - cur[0] + b0.x) * c0.x; o[1] = (s[1] * inv - cur[1] + b0.y) * c0.y; o[2] = (s[2] * inv - cur[2] + b0.z) * c0.z; o[3] = (s[3] * inv - cur[3] + b0.w) * c0.w;
                o[4] = (s[4] * inv - cur[4] + b1.x) * c1.x; o[5] = (s[5] * inv - cur[5] + b1.y) * c1.y; o[6] = (s[6] * inv - cur[6] + b1.z) * c1.z; o[7] = (s[7] * inv - cur[7] + b1.w) * c1.w;
                v4u ov; ov.x = pk2(o[0], o[1]); ov.y = pk2(o[2], o[3]); ov.z = pk2(o[4], o[5]); ov.w = pk2(o[6], o[7]);
                *(v4u*)(YA + (size_t)t * NMIX + ch) = ov;
            }
        }
    }
}
__device__ __forceinline__ unsigned f2key(float f) { const unsigned b = __float_as_uint(f); return b ^ ((unsigned)((int)b >> 31) | 0x80000000u); }
__device__ __forceinline__ float key2f(unsigned u) { const unsigned b = (u & 0x80000000u) ? (u ^ 0x80000000u) : ~u; return __uint_as_float(b); }
#define INSK(L, kk) do { unsigned _v = (kk); _Pragma("unroll") for (int _j = 0; _j < 16; ++_j) { const unsigned _t = L[_j] > _v ? L[_j] : _v; _v = L[_j] > _v ? _v : L[_j]; L[_j] = _t; } } while (0)
__device__ __forceinline__ void route_phase(const Ctx& X, const bf16* Q, const bf16* KEYS_l, int* IDX, float* GATE) {
    LAS bf16* KL = (LAS bf16*)X.lds;
    const int r = X.lane & 31, h = X.lane >> 5;
    for (int u = X.bid; u < (M / 256) * 8; u += X.G) {
        const int tb = u >> 3, hd = u & 7;
        for (int i = X.tid; i < 4096; i += NT) { const int half = i >> 11, row = (i >> 4) & 127, ck = i & 15;
            const v4u v = *(const v4u*)(KEYS_l + ((size_t)(half * 8 + hd) * 128 + row) * 128 + ck * 8);
            *(LAS v4u*)(KL + (half * 128 + row) * 136 + ck * 8) = v; }
        __syncthreads();
        const int tok = tb * 256 + X.wave * 32 + r;
        unsigned K1[16], L[16];
#pragma unroll
        for (int half = 0; half < 2; ++half) {
            f32x16 acc[4];
#pragma unroll
            for (int mt = 0; mt < 4; ++mt)
#pragma unroll
                for (int i = 0; i < 16; ++i) acc[mt][i] = 0.f;
            const bf16* qrow = Q + (size_t)tok * NQ + hd * 256 + half * 128;
#pragma unroll
            for (int ks = 0; ks < 8; ++ks) { const int k0 = 16 * ks + 8 * h; const bf16x8 qb = *(const bf16x8*)(qrow + k0);
#pragma unroll
                for (int mt = 0; mt < 4; ++mt) acc[mt] = MFMA32(*(const LAS bf16x8*)(KL + (half * 128 + 32 * mt + r) * 136 + k0), qb, acc[mt]); }
#pragma unroll
            for (int j = 0; j < 16; ++j) L[j] = 0u;
#pragma unroll
            for (int mt = 0; mt < 4; ++mt)
#pragma unroll
                for (int i = 0; i < 16; ++i) INSK(L, (f2key(acc[mt][i]) & ~127u) | (unsigned)(32 * mt + rowoff(i, h)));
            unsigned S[16];
#pragma unroll
            for (int j = 0; j < 16; ++j) S[j] = (unsigned)__shfl_xor((int)L[j], 32);
#pragma unroll
            for (int j = 0; j < 16; ++j) INSK(L, S[j]);
            if (half == 0) {
#pragma unroll
                for (int j = 0; j < 16; ++j) K1[j] = L[j];
            }
        }
        float V1[16], V2[16];
#pragma unroll
        for (int j = 0; j < 16; ++j) { V1[j] = key2f(K1[j] & ~127u); V2[j] = key2f(L[j] & ~127u); }
        unsigned C[16];
#pragma unroll
        for (int j = 0; j < 16; ++j) C[j] = 0u;
#pragma unroll
        for (int a = 0; a < 16; ++a)
#pragma unroll
            for (int b = 0; b < 16; ++b) if ((a + 1) * (b + 1) <= 16) INSK(C, (f2key(V1[a] + V2[b]) & ~255u) | (unsigned)(a * 16 + b));
        float e[16], s = 0.f; const float top = key2f(C[0] & ~255u);
#pragma unroll
        for (int j = 0; j < 16; ++j) { e[j] = __expf(key2f(C[j] & ~255u) - top); s += e[j]; }
        const float inv = 1.0f / s;
        int* ip = IDX + (size_t)tok * 128 + hd * 16; float* gp = GATE + (size_t)tok * 128 + hd * 16;
#pragma unroll
        for (int j = 0; j < 16; ++j) {
            const unsigned a = (C[j] >> 4) & 15u, b = C[j] & 15u;
            unsigned i1 = K1[0], i2 = L[0];
#pragma unroll
            for (int q = 1; q < 16; ++q) { i1 = (a == (unsigned)q) ? K1[q] : i1; i2 = (b == (unsigned)q) ? L[q] : i2; }
            if (h == (j >> 3)) { ip[j] = (int)((i1 & 127u) * 128u + (i2 & 127u)); gp[j] = e[j] * inv; }
        }
        __syncthreads();
    }
}
__device__ __forceinline__ float gelu_erf(float x) { return 0.5f * x * (1.0f + erff(x * 0.70710678118654752f)); }
__device__ __forceinline__ void expert_phase(const Ctx& X, const bf16* XN, const int* IDX, const float* GATE, const bf16* ED, const bf16* EU, const float* x1, const float* gate_f, float* xout, const float* norm_final, bool final_norm) {
    const int gw = X.bid * NWAVES + X.wave, NGW = X.G * NWAVES;
    for (int t = gw; t < M; t += NGW) {
        const int b = t >> 12;
        float hf[16], out[16];
        { const v4u h0 = *(const v4u*)(XN + (size_t)t * DM + 8 * X.lane), h1 = *(const v4u*)(XN + (size_t)t * DM + 512 + 8 * X.lane);
          hf[0] = bflo(h0.x); hf[1] = bfhi(h0.x); hf[2] = bflo(h0.y); hf[3] = bfhi(h0.y); hf[4] = bflo(h0.z); hf[5] = bfhi(h0.z); hf[6] = bflo(h0.w); hf[7] = bfhi(h0.w);
          hf[8] = bflo(h1.x); hf[9] = bfhi(h1.x); hf[10] = bflo(h1.y); hf[11] = bfhi(h1.y); hf[12] = bflo(h1.z); hf[13] = bfhi(h1.z); hf[14] = bflo(h1.w); hf[15] = bfhi(h1.w); }
#pragma unroll
        for (int i = 0; i < 16; ++i) out[i] = 0.f;
        const int id0 = IDX[(size_t)t * 128 + X.lane], id1 = IDX[(size_t)t * 128 + 64 + X.lane];
        const float g0 = GATE[(size_t)t * 128 + X.lane], g1 = GATE[(size_t)t * 128 + 64 + X.lane];
#pragma unroll 4
        for (int k = 0; k < 128; ++k) {
            const int e = (k < 64) ? __builtin_amdgcn_readlane(id0, k & 63) : __builtin_amdgcn_readlane(id1, k & 63);
            const float gk = (k < 64) ? __uint_as_float(__builtin_amdgcn_readlane(__float_as_uint(g0), k & 63)) : __uint_as_float(__builtin_amdgcn_readlane(__float_as_uint(g1), k & 63));
            const bf16* dr = ED + (size_t)e * DM + 8 * X.lane; const bf16* ur = EU + (size_t)e * DM + 8 * X.lane;
            const v4u d0 = *(const v4u*)dr, d1 = *(const v4u*)(dr + 512), u0 = *(const v4u*)ur, u1 = *(const v4u*)(ur + 512);
            float dot = hf[0] * bflo(d0.x) + hf[1] * bfhi(d0.x) + hf[2] * bflo(d0.y) + hf[3] * bfhi(d0.y) + hf[4] * bflo(d0.z) + hf[5] * bfhi(d0.z) + hf[6] * bflo(d0.w) + hf[7] * bfhi(d0.w)
                      + hf[8] * bflo(d1.x) + hf[9] * bfhi(d1.x) + hf[10] * bflo(d1.y) + hf[11] * bfhi(d1.y) + hf[12] * bflo(d1.z) + hf[13] * bfhi(d1.z) + hf[14] * bflo(d1.w) + hf[15] * bfhi(d1.w);
            dot = wave_sum(dot);
            const float cf = gk * gelu_erf(dot);
            out[0] += cf * bflo(u0.x); out[1] += cf * bfhi(u0.x); out[2] += cf * bflo(u0.y); out[3] += cf * bfhi(u0.y); out[4] += cf * bflo(u0.z); out[5] += cf * bfhi(u0.z); out[6] += cf * bflo(u0.w); out[7] += cf * bfhi(u0.w);
            out[8] += cf * bflo(u1.x); out[9] += cf * bfhi(u1.x); out[10] += cf * bflo(u1.y); out[11] += cf * bfhi(u1.y); out[12] += cf * bflo(u1.z); out[13] += cf * bfhi(u1.z); out[14] += cf * bflo(u1.w); out[15] += cf * bfhi(u1.w);
        }
        float ss = 0.f; float xo[16];
#pragma unroll
        for (int hfi = 0; hfi < 2; ++hfi)
#pragma unroll
            for (int q4 = 0; q4 < 2; ++q4) { const int col = hfi * 512 + 8 * X.lane + 4 * q4;
                const f32x4 xv = *(const f32x4*)(x1 + (size_t)t * DM + col), gv = *(const f32x4*)(gate_f + (size_t)b * 6144 + col);
                const int o = hfi * 8 + q4 * 4;
                xo[o + 0] = xv.x + gv.x * out[o + 0]; xo[o + 1] = xv.y + gv.y * out[o + 1]; xo[o + 2] = xv.z + gv.z * out[o + 2]; xo[o + 3] = xv.w + gv.w * out[o + 3];
                ss += (xo[o] * xo[o] + xo[o + 1] * xo[o + 1]) + (xo[o + 2] * xo[o + 2] + xo[o + 3] * xo[o + 3]); }
        float rstd = 1.f;
        if (final_norm) { ss = wave_sum(ss); rstd = 1.0f / sqrtf(ss * (1.f / DM) + EPS); }
#pragma unroll
        for (int hfi = 0; hfi < 2; ++hfi)
#pragma unroll
            for (int q4 = 0; q4 < 2; ++q4) { const int col = hfi * 512 + 8 * X.lane + 4 * q4; const int o = hfi * 8 + q4 * 4;
                f32x4 ov = {xo[o], xo[o + 1], xo[o + 2], xo[o + 3]};
                if (final_norm) { const f32x4 nf = *(const f32x4*)(norm_final + col); ov = ov * rstd * nf; }
                *(f32x4*)(xout + (size_t)t * DM + col) = ov; }
    }
}

struct Args { const float* in[23]; float* out; unsigned char* ws; };
#define AS4 __attribute__((address_space(4)))
__device__ __forceinline__ const AS4 Args* kargs() { const AS4 Args* p = (const AS4 Args*)__builtin_amdgcn_kernarg_segment_ptr(); asm volatile("" : "+s"(p)); return p; }
#define KIN(i) (kargs()->in[i])
#define WSP(T, off) ((T*)(kargs()->ws + (off)))
__global__ void __launch_bounds__(NT, 2) fwd_kernel(Args args_unused) {
    extern __shared__ __attribute__((aligned(16))) unsigned char lds_raw[];
    Ctx X; X.lds = (LAS unsigned char*)lds_raw; X.tid = threadIdx.x; X.lane = X.tid & 63; X.wave = __builtin_amdgcn_readfirstlane(X.tid >> 6); X.G = gridDim.x; X.bid = blockIdx.x;
    volatile LAS unsigned* MISC = (volatile LAS unsigned*)(X.lds + MISC_OFF);
    for (int u = X.tid; u < (LDS_BYTES - LDSCTL_OFF) / 4; u += NT) ((LAS unsigned*)(X.lds + LDSCTL_OFF))[u] = 0u;
    __syncthreads();
    XcdBarrier bar = xcd_barrier_post(WSP(unsigned, WS_CTL) + CW_BAR, MISC + 8);
#define GRID_BAR() xcd_barrier(bar)

#ifndef NO_PH_MOD
    p0_mod(fresh(X), KIN(1), KIN(2), KIN(3), WSP(float, WS_MOD));
#endif
#ifndef NO_PH_FOLD
    p0_fold(fresh(X), KIN(6), KIN(7), WSP(float, WS_WF));
#endif
    p0_cvt(fresh(X), KIN(20), WSP(bf16, WS_ED), (size_t)2 * 16384 * 1024 / 8);
    p0_cvt(fresh(X), KIN(21), WSP(bf16, WS_EU), (size_t)2 * 16384 * 1024 / 8);
    for (int l = 0; l < 2; ++l) { p0_cvt(fresh(X), KIN(18) + (size_t)l * 131072, WSP(bf16, WS_KEYS) + (size_t)(l * 2 + 0) * 131072, 131072 / 8); p0_cvt(fresh(X), KIN(19) + (size_t)l * 131072, WSP(bf16, WS_KEYS) + (size_t)(l * 2 + 1) * 131072, 131072 / 8); }
    GRID_BAR();
#ifndef NO_PH_TR
    p0_transposes(fresh(X), KIN(6), WSP(float, WS_WF), KIN(16), KIN(17), WSP(bf16, WS_WIN), WSP(bf16, WS_WOUT), WSP(bf16, WS_WQ));
#endif
    __syncthreads();

    for (int l = 0; l < 2; ++l) {
        {
            const float* xin = (l == 0) ? KIN(0) : WSP(float, WS_X2); const float* modl = WSP(float, WS_MOD) + (size_t)l * 4 * 6144;
            norm_mod_phase(fresh(X), xin, KIN(4) + l * DM, modl + 0 * DM, modl + 1 * DM, WSP(bf16, WS_XN));
        }
        GRID_BAR();
        {
            pg8::Gemm g{WSP(bf16, WS_XN), WSP(bf16, WS_WIN) + (size_t)l * NPROJ_PAD * 1024, M, NPROJ_PAD, DM}; const Ctx Y = fresh(X); pg8::StaticOrder S; S.init(M, NPROJ_PAD, Y.G, Y.bid);
            pg8::EpiStore E{WSP(bf16, WS_PROJ), PROJ_LD, 12, WSP(float, WS_DTRAW), 16, 16};
            pg8::gemm_phase<pg8::EpiStore, pg8::StaticOrder, true, true>(X.lds, g, S, E);
        }
        GRID_BAR();
#ifndef NO_PH_CV
        conv_phase(fresh(X), WSP(bf16, WS_PROJ), KIN(10) + (size_t)l * 4 * 1536, KIN(11) + (size_t)l * 1536, WSP(bf16, WS_CBC), WSP(bf16, WS_XBT));
#endif
        GRID_BAR();
#ifndef NO_PH_S1
        ssd_states_phase(fresh(X), WSP(float, WS_DTRAW), KIN(12) + l * 16, KIN(13) + l * 16, WSP(bf16, WS_XBT), WSP(float, WS_DTV), WSP(float, WS_ACS), WSP(float, WS_CD), WSP(bf16, WS_ST));
#endif
        GRID_BAR();
#ifndef NO_PH_S2
        ssd_scan_phase(fresh(X), WSP(bf16, WS_ST), WSP(float, WS_CD));
#endif
        GRID_BAR();
#ifndef NO_PH_S3
        ssd_out_phase(fresh(X), WSP(bf16, WS_CBC), WSP(bf16, WS_XBT), WSP(bf16, WS_ST), WSP(float, WS_DTV), WSP(float, WS_ACS), KIN(14) + l * 16, WSP(bf16, WS_PROJ), WSP(bf16, WS_XN), WSP(float, WS_SSQ));
#endif
        GRID_BAR();
#ifndef NO_PH_S4
        mix_finish_phase(fresh(X), WSP(bf16, WS_PROJ), WSP(float, WS_SSQ), KIN(15) + l * DM, KIN(8) + l * 512, KIN(9) + l * 512, WSP(bf16, WS_XN));
#endif
        GRID_BAR();
        {
            const float* xin = (l == 0) ? KIN(0) : WSP(float, WS_X2);
            pg8::Gemm g{WSP(bf16, WS_XN), WSP(bf16, WS_WOUT) + (size_t)l * 1024 * NMIX, M, DM, NMIX}; const Ctx Y = fresh(X); pg8::StaticOrder S; S.init(M, DM, Y.G, Y.bid);
            pg8::EpiResid E{xin, kargs()->out, WSP(float, WS_MOD) + (size_t)l * 4 * 6144 + 2 * DM};
            pg8::gemm_phase<pg8::EpiResid, pg8::StaticOrder, true, true>(X.lds, g, S, E);
        }
        GRID_BAR();
        {
            const float* modl = WSP(float, WS_MOD) + (size_t)l * 4 * 6144;
            norm_mod_phase(fresh(X), kargs()->out, KIN(5) + l * DM, modl + 3 * DM, modl + 4 * DM, WSP(bf16, WS_XN));
        }
        GRID_BAR();
        {
            pg8::Gemm g{WSP(bf16, WS_XN), WSP(bf16, WS_WQ) + (size_t)l * NQ * 1024, M, NQ, DM}; const Ctx Y = fresh(X); pg8::StaticOrder S; S.init(M, NQ, Y.G, Y.bid);
            pg8::EpiStore E{WSP(bf16, WS_PROJ), NQ, 1 << 30, nullptr, 0, 0};
            pg8::gemm_phase<pg8::EpiStore, pg8::StaticOrder, true, true>(X.lds, g, S, E);
        }
        GRID_BAR();
#ifndef NO_PH_R1
        route_phase(fresh(X), WSP(bf16, WS_PROJ), WSP(bf16, WS_KEYS) + (size_t)l * 2 * 131072, WSP(int, WS_IDX), WSP(float, WS_GATE));
#endif
        GRID_BAR();
#ifndef NO_PH_E1
        expert_phase(fresh(X), WSP(bf16, WS_XN), WSP(int, WS_IDX), WSP(float, WS_GATE), WSP(bf16, WS_ED) + (size_t)l * 16384 * 1024, WSP(bf16, WS_EU) + (size_t)l * 16384 * 1024, kargs()->out,
                     WSP(float, WS_MOD) + (size_t)l * 4 * 6144 + 5 * DM, (l == 0) ? WSP(float, WS_X2) : kargs()->out, KIN(22), l == 1);
#endif
        if (l == 0) GRID_BAR();
    }
}

extern "C" void kernel_launch(void* const* d_in, const int* in_sizes, int n_in, void* d_out, int out_size, void* d_ws, size_t ws_size, hipStream_t stream) {
    static int grid = 0;
    if (grid == 0) {
        if (n_in != 23 || out_size != M * DM || ws_size < WS_END) { fprintf(stderr, "kernel_launch: unexpected shapes (n_in %d, out %d, ws %zu); nothing launched\n", n_in, out_size, ws_size); grid = -1; return; }
        int dev = 0, cus = 0, per_cu = 0;
        if (hipGetDevice(&dev) != hipSuccess || hipDeviceGetAttribute(&cus, hipDeviceAttributeMultiprocessorCount, dev) != hipSuccess) { grid = -1; return; }
        if (hipFuncSetAttribute((const void*)fwd_kernel, hipFuncAttributeMaxDynamicSharedMemorySize, LDS_BYTES) != hipSuccess) { fprintf(stderr, "kernel_launch: hipFuncSetAttribute failed\n"); grid = -1; return; }
        if (hipOccupancyMaxActiveBlocksPerMultiprocessor(&per_cu, (const void*)fwd_kernel, NT, LDS_BYTES) != hipSuccess || per_cu < 1) { fprintf(stderr, "kernel_launch: occupancy query says %d\n", per_cu); }
        (void)hipGetLastError();
        grid = cus;
    }
    if (grid < 0) return;
    if (hipMemsetAsync((char*)d_ws + WS_CTL, 0, CTL_ZERO_BYTES, stream) != hipSuccess) { fprintf(stderr, "kernel_launch: memset failed\n"); return; }
    Args a{};
    for (int i = 0; i < 23; ++i) a.in[i] = (const float*)d_in[i];
    a.out = (float*)d_out; a.ws = (unsigned char*)d_ws;
    hipLaunchKernelGGL(fwd_kernel, dim3(grid), dim3(NT), LDS_BYTES, stream, a);
}
```

```cpp
#include <hip/hip_runtime.h>
#include <cstdio>
#include <cstdint>
namespace pg8 {
#define PG8_LAS __attribute__((address_space(3)))
typedef unsigned short bf16_t;
typedef short bf16x8 __attribute__((ext_vector_type(8)));
typedef float f32x4 __attribute__((ext_vector_type(4)));
typedef unsigned u32x4 __attribute__((ext_vector_type(4)));
constexpr int BM = 256, BK = 64, HALF = 128, HTB = HALF * BK * 2  , STAGE_BYTES = 8 * HTB, NXCD = 8, WGM = 8;

__host__ __device__ __forceinline__ int lds_byte(int r, int c) { const int st = (r >> 4) * 2 + (c >> 5), rr = r & 15, cc = c & 31, ob = rr * 64 + cc * 2; return st * 1024 + (ob ^ (((ob >> 9) & 1) << 5)); }
__host__ __device__ __forceinline__ void stage_rc(int b, int& R, int& C) { const int st = b / 1024, sb = b % 1024, swz = sb ^ (((sb >> 9) & 1) << 5); R = (st >> 1) * 16 + swz / 64; C = (st & 1) * 32 + (swz % 64) / 2; }
__host__ __device__ __forceinline__ int perm32(int rho) { const int n = rho >> 4, i = rho & 15; return 8 * (i >> 2) + 4 * n + (i & 3); }

struct Unit { int pm, pn; };
struct Gemm { const bf16_t* A; const bf16_t* Bt; int M, N, K; };

struct StaticOrder {
    int nM, nN, nwg, G, c;
    __host__ __device__ void init(int M, int N, int G_, int c_) { nM = M / BM; nN = N / BM; nwg = nM * nN; G = G_; c = c_; }
    __host__ __device__ bool next(int i, Unit& u) const {
        const long L = (long)i * G + c; if (L >= nwg) return false;
        int wgid = (int)L; { const int q = nwg / NXCD, r = nwg % NXCD, xcd = wgid % NXCD, off = wgid / NXCD; wgid = (xcd < r ? xcd * (q + 1) : r * (q + 1) + (xcd - r) * q) + off; }
        const int nig = WGM * nN, gid = wgid / nig, fm = gid * WGM, gsz = (nM - fm) < WGM ? (nM - fm) : WGM;
        u.pm = fm + ((wgid % nig) % gsz); u.pn = (wgid % nig) / gsz; return true;
    }
    __device__ __forceinline__ void a_ready(const Unit&) const {}
    __device__ __forceinline__ void done(const Unit&) const {}
};


__device__ __forceinline__ unsigned cvt_pk_bf16(float lo, float hi) { unsigned r; asm volatile("v_cvt_pk_bf16_f32 %0, %1, %2" : "=v"(r) : "v"(lo), "v"(hi)); return r; }

struct EpiStore {
    static constexpr bool PERM = true, AFTER_DRAIN = false;
    bf16_t* O; int ldc; int pn_f32; float* F32; int ld32; int ncol32;
    __device__ __forceinline__ void operator()(const f32x4 (&acc)[2][2][4][2], const Unit& u, int wr, int wc, int fr, int fq) const {
        const int row0 = u.pm * BM + wr * 64 + fr;
        if (u.pn >= pn_f32) {
#pragma unroll
            for (int ai = 0; ai < 2; ++ai)
#pragma unroll
                for (int m = 0; m < 4; ++m) { const size_t row = (size_t)(row0 + ai * HALF + m * 16);
#pragma unroll
                    for (int bj = 0; bj < 2; ++bj)
#pragma unroll
                        for (int n = 0; n < 2; ++n) { const int c0 = bj * HALF + wc * 32 + 8 * fq + 4 * n;
#pragma unroll
                            for (int j = 0; j < 4; ++j) if (c0 + j < ncol32) F32[row * ld32 + c0 + j] = acc[ai][bj][m][n][j]; } }
            return;
        }
        const int col0 = u.pn * BM + wc * 32 + 8 * fq;
#pragma unroll
        for (int ai = 0; ai < 2; ++ai)
#pragma unroll
            for (int m = 0; m < 4; ++m) { bf16_t* rowp = O + (size_t)(row0 + ai * HALF + m * 16) * ldc + col0;
#pragma unroll
                for (int bj = 0; bj < 2; ++bj) { const f32x4 v0 = acc[ai][bj][m][0], v1 = acc[ai][bj][m][1];
                    u32x4 w; w.x = cvt_pk_bf16(v0[0], v0[1]); w.y = cvt_pk_bf16(v0[2], v0[3]); w.z = cvt_pk_bf16(v1[0], v1[1]); w.w = cvt_pk_bf16(v1[2], v1[3]);
                    *(u32x4*)(rowp + bj * HALF) = w; } }
    }
};

struct EpiResid {
    static constexpr bool PERM = false, AFTER_DRAIN = false;
    const float* xin; float* out; const float* gate;
    __device__ __forceinline__ void operator()(const f32x4 (&acc)[2][2][4][2], const Unit& u, int wr, int wc, int fr, int fq) const {
        const int col0 = u.pn * BM + wc * 32 + 4 * fq;
#pragma unroll
        for (int ai = 0; ai < 2; ++ai)
#pragma unroll
            for (int m = 0; m < 4; ++m) { const int row = u.pm * BM + ai * HALF + wr * 64 + m * 16 + fr; const int b = row >> 12; const size_t off = (size_t)row * 1024 + col0;
#pragma unroll
                for (int bj = 0; bj < 2; ++bj)
#pragma unroll
                    for (int n = 0; n < 2; ++n) { const int cc = bj * HALF + n * 16;
                        const f32x4 g = *(const f32x4*)(gate + (size_t)b * 6144 + col0 + cc); const f32x4 x = *(const f32x4*)(xin + off + cc);
                        *(f32x4*)(out + off + cc) = x + g * acc[ai][bj][m][n]; } }
    }
};
template <class Epi, class Sched, bool ALIGN_EPI = false, bool SP2 = false>
__device__ __forceinline__ void gemm_phase(PG8_LAS unsigned char* lds, const Gemm g, const Sched& S, const Epi& E) {
    int tid_ = threadIdx.x; asm volatile("" : "+v"(tid_));
    const int tid = tid_, wid = __builtin_amdgcn_readfirstlane(tid >> 6), lane = tid & 63, wr = wid >> 2, wc = wid & 3, fr = lane & 15, fq = lane >> 4;
    const int K = g.K, nt = K / BK;
    unsigned voffA[2], voffB[2];
#pragma unroll
    for (int i = 0; i < 2; ++i) { int R, C; stage_rc(tid * 16 + i * 8192, R, C); const int Rb = Epi::PERM ? ((R & ~31) + perm32(R & 31)) : R;
        voffA[i] = (unsigned)(R * K + C) * 2u; voffB[i] = (unsigned)(Rb * K + C) * 2u; }
    const size_t kstep = (size_t)(BK * 2);
    const size_t hstep = (size_t)HALF * K * 2;
    const size_t tstep = 2 * hstep;
    const unsigned ldsw = (unsigned)wid * 1024u;
    const int aoff = lds_byte(wr * 64 + fr, fq * 8), boff = lds_byte(wc * 32 + fr, fq * 8);
#define PG8_SA(b, h) (((b) * 2 + (h)) * HTB)
#define PG8_SB(b, h) ((4 + (b) * 2 + (h)) * HTB)
#define PG8_STAGE(bufoff, gbase, voff) do { _Pragma("unroll") for (int _i = 0; _i < 2; ++_i) \
        __builtin_amdgcn_global_load_lds((const unsigned*)((const char*)(gbase) + (voff)[_i]), (PG8_LAS unsigned*)(lds + (bufoff) + ldsw + _i * 8192), 16, 0, 0); } while (0)
#define PG8_LDA(dst, b, h) do { _Pragma("unroll") for (int m = 0; m < 4; ++m) _Pragma("unroll") for (int k = 0; k < 2; ++k) dst[m][k] = *(const PG8_LAS bf16x8*)(lds + PG8_SA(b, h) + aoff + m * 2048 + k * 1024); } while (0)
#define PG8_LDB(dst, b, h) do { _Pragma("unroll") for (int n = 0; n < 2; ++n) _Pragma("unroll") for (int k = 0; k < 2; ++k) dst[n][k] = *(const PG8_LAS bf16x8*)(lds + PG8_SB(b, h) + boff + n * 2048 + k * 1024); } while (0)
#define PG8_MMA(ai, bj, At, Bt) do { __builtin_amdgcn_s_setprio(1); _Pragma("unroll") for (int m = 0; m < 4; ++m) _Pragma("unroll") for (int n = 0; n < 2; ++n) _Pragma("unroll") for (int k = 0; k < 2; ++k) \
        acc[ai][bj][m][n] = __builtin_amdgcn_mfma_f32_16x16x32_bf16(Bt[n][k], At[m][k], acc[ai][bj][m][n], 0, 0, 0); __builtin_amdgcn_s_setprio(0); } while (0)
#define PG8_WAIT_V(n) asm volatile("s_waitcnt vmcnt(" #n ")" ::: "memory")
#define PG8_WAIT_L(n) asm volatile("s_waitcnt lgkmcnt(" #n ")" ::: "memory")
#define PG8_BAR __builtin_amdgcn_s_barrier()
#define PG8_SCHED __builtin_amdgcn_sched_barrier(0)
    Unit cur, nxt; int ui = 0;
    if (!S.next(0, cur)) return;
    f32x4 acc[2][2][4][2];
#pragma unroll
    for (int a = 0; a < 2; ++a)
#pragma unroll
        for (int b = 0; b < 2; ++b)
#pragma unroll
            for (int m = 0; m < 4; ++m)
#pragma unroll
                for (int n = 0; n < 2; ++n) acc[a][b][m][n] = (f32x4){0.f, 0.f, 0.f, 0.f};
    bf16x8 At[4][2], B0[2][2], B1[2][2];
    const char* cA = (const char*)g.A + (size_t)cur.pm * tstep; const char* cB = (const char*)g.Bt + (size_t)cur.pn * tstep;
    S.a_ready(cur);
    if constexpr (SP2) {
        PG8_STAGE(PG8_SB(0, 0), cB, voffB); PG8_STAGE(PG8_SB(0, 1), cB + hstep, voffB); PG8_STAGE(PG8_SA(0, 0), cA, voffA); PG8_STAGE(PG8_SA(0, 1), cA + hstep, voffA);
        if (wr == 1) PG8_BAR;
        PG8_WAIT_V(2); PG8_BAR;
        PG8_STAGE(PG8_SB(1, 0), cB + kstep, voffB); PG8_STAGE(PG8_SA(1, 0), cA + kstep, voffA); PG8_STAGE(PG8_SB(1, 1), cB + hstep + kstep, voffB);
        PG8_WAIT_V(6); PG8_BAR;
    } else {
        PG8_STAGE(PG8_SB(0, 0), cB, voffB); PG8_STAGE(PG8_SA(0, 0), cA, voffA); PG8_STAGE(PG8_SB(0, 1), cB + hstep, voffB); PG8_STAGE(PG8_SA(0, 1), cA + hstep, voffA);
        if (wr == 1) PG8_BAR;
        PG8_WAIT_V(4); PG8_BAR;
        PG8_STAGE(PG8_SB(1, 0), cB + kstep, voffB); PG8_STAGE(PG8_SA(1, 0), cA + kstep, voffA); PG8_STAGE(PG8_SB(1, 1), cB + hstep + kstep, voffB);
        PG8_WAIT_V(6); PG8_BAR;
    }
    for (;;) {
        const bool has_next = S.next(ui + 1, nxt);
        const char* nA = has_next ? (const char*)g.A + (size_t)nxt.pm * tstep : cA; const char* nB = has_next ? (const char*)g.Bt + (size_t)nxt.pn * tstep : cB;
        for (int t = 0; t < nt; t += 2) {
            const bool last = (t == nt - 2);
            const char* a1 = cA + (size_t)(t + 1) * kstep;
            const char* a2 = last ? nA : cA + (size_t)(t + 2) * kstep; const char* b2 = last ? nB : cB + (size_t)(t + 2) * kstep;
            const char* a3 = a2 + kstep; const char* b3 = b2 + kstep;
            if (last && has_next) S.a_ready(nxt);
            if constexpr (SP2) {
            PG8_LDB(B0, 0, 0); PG8_LDB(B1, 0, 1); PG8_SCHED; PG8_LDA(At, 0, 0); PG8_STAGE(PG8_SA(1, 1), a1 + hstep, voffA);
            PG8_WAIT_V(8); PG8_WAIT_L(0); PG8_BAR; PG8_MMA(0, 0, At, B0); PG8_MMA(0, 1, At, B1); PG8_BAR; PG8_SCHED;
            PG8_LDA(At, 0, 1); PG8_STAGE(PG8_SB(0, 0), b2, voffB); PG8_STAGE(PG8_SB(0, 1), b2 + hstep, voffB); PG8_STAGE(PG8_SA(0, 0), a2, voffA);
            PG8_WAIT_V(8); PG8_WAIT_L(0); PG8_BAR; PG8_MMA(1, 0, At, B0); PG8_MMA(1, 1, At, B1); PG8_BAR; PG8_SCHED;
            PG8_LDB(B0, 1, 0); PG8_LDB(B1, 1, 1); PG8_SCHED; PG8_LDA(At, 1, 0); PG8_STAGE(PG8_SA(0, 1), a2 + hstep, voffA);
            PG8_WAIT_V(8); PG8_WAIT_L(0); PG8_BAR; PG8_MMA(0, 0, At, B0); PG8_MMA(0, 1, At, B1); PG8_BAR; PG8_SCHED;
            PG8_LDA(At, 1, 1); PG8_STAGE(PG8_SB(1, 0), b3, voffB); PG8_STAGE(PG8_SB(1, 1), b3 + hstep, voffB); PG8_STAGE(PG8_SA(1, 0), a3, voffA);
            PG8_WAIT_V(8); PG8_WAIT_L(0); PG8_BAR; PG8_MMA(1, 0, At, B0); PG8_MMA(1, 1, At, B1); PG8_BAR; PG8_SCHED;
            } else {
            PG8_LDB(B0, 0, 0); PG8_SCHED; PG8_LDA(At, 0, 0); PG8_STAGE(PG8_SA(1, 1), a1 + hstep, voffA);
            PG8_WAIT_L(8); PG8_BAR; PG8_WAIT_L(0); PG8_MMA(0, 0, At, B0); PG8_BAR; PG8_SCHED;
            PG8_LDB(B1, 0, 1); PG8_STAGE(PG8_SB(0, 0), b2, voffB);
            PG8_BAR; PG8_WAIT_L(0); PG8_MMA(0, 1, At, B1); PG8_BAR;
            PG8_LDA(At, 0, 1); PG8_STAGE(PG8_SA(0, 0), a2, voffA);
            PG8_BAR; PG8_WAIT_L(0); PG8_MMA(1, 0, At, B0); PG8_BAR; PG8_SCHED;
            PG8_STAGE(PG8_SB(0, 1), b2 + hstep, voffB);
            PG8_WAIT_V(6); PG8_BAR; PG8_MMA(1, 1, At, B1); PG8_BAR;
            PG8_LDB(B0, 1, 0); PG8_SCHED; PG8_LDA(At, 1, 0); PG8_STAGE(PG8_SA(0, 1), a2 + hstep, voffA);
            PG8_WAIT_L(8); PG8_BAR; PG8_WAIT_L(0); PG8_MMA(0, 0, At, B0); PG8_BAR; PG8_SCHED;
            PG8_LDB(B1, 1, 1); PG8_STAGE(PG8_SB(1, 0), b3, voffB);
            PG8_BAR; PG8_WAIT_L(0); PG8_MMA(0, 1, At, B1); PG8_BAR;
            PG8_LDA(At, 1, 1); PG8_STAGE(PG8_SA(1, 0), a3, voffA);
            PG8_BAR; PG8_WAIT_L(0); PG8_MMA(1, 0, At, B0); PG8_BAR; PG8_SCHED;
            PG8_STAGE(PG8_SB(1, 1), b3 + hstep, voffB);
            PG8_WAIT_V(6); PG8_BAR; PG8_MMA(1, 1, At, B1); PG8_BAR;
            }
        }
        if constexpr (ALIGN_EPI) { if (wr == 0) PG8_BAR; }
        if constexpr (!Epi::AFTER_DRAIN) { E(acc, cur, wr, wc, fr, fq); S.done(cur); }
        if (!has_next) break;
#pragma unroll
        for (int a = 0; a < 2; ++a)
#pragma unroll
            for (int b = 0; b < 2; ++b)
#pragma unroll
                for (int m = 0; m < 4; ++m)
#pragma unroll
                    for (int n = 0; n < 2; ++n) acc[a][b][m][n] = (f32x4){0.f, 0.f, 0.f, 0.f};
        cur = nxt; cA = nA; cB = nB; ++ui;
        if constexpr (ALIGN_EPI) { if (wr == 1) PG8_BAR; }
    }
    PG8_WAIT_V(0);
    if constexpr (!ALIGN_EPI) { if (wr == 0) PG8_BAR; }
    PG8_BAR;
    if constexpr (Epi::AFTER_DRAIN) { E.fused(acc, cur, wr, wc, fr, fq, lds, wid, lane); S.done(cur); }
#undef PG8_SA
#undef PG8_SB
#undef PG8_STAGE
#undef PG8_LDA
#undef PG8_LDB
#undef PG8_MMA
#undef PG8_WAIT_V
#undef PG8_WAIT_L
#undef PG8_BAR
#undef PG8_SCHED
}
}
#define GAS __attribute__((address_space(1)))
#define LAS __attribute__((address_space(3)))
typedef unsigned short bf16;
typedef unsigned v4u __attribute__((ext_vector_type(4)));
typedef float f32x4 __attribute__((ext_vector_type(4)));
typedef short bf16x8 __attribute__((ext_vector_type(8)));
typedef GAS unsigned gu32;
typedef GAS unsigned long long gu64;
#define RLX_AGENT __ATOMIC_RELAXED, __HIP_MEMORY_SCOPE_AGENT
#define LDS_WAIT() asm volatile("s_waitcnt lgkmcnt(0)" ::: "memory")
#define VM_WAIT() asm volatile("s_waitcnt vmcnt(0)" ::: "memory")
__device__ __forceinline__ unsigned long long rt() { return __builtin_amdgcn_s_memrealtime(); }
__device__ __forceinline__ unsigned f2bf(float f) { unsigned u = __builtin_bit_cast(unsigned, f); return (u + 0x7fffu + ((u >> 16) & 1u)) >> 16; }
__device__ __forceinline__ unsigned pk2(float lo, float hi) { return f2bf(lo) | (f2bf(hi) << 16); }

#define XB_TMO      128
#define XB_XCNT(j)  (256  + 64 * (j))
#define XB_XSUB(j)  (1280 + 64 * (j))
#define XB_XGEN(j)  (2304 + 64 * (j))
#define XB_TOP      3328
#define XB_TOPGEN   3392
#define XCD_BAR_WORDS 3456
#define XB_SPIN_CAP (1u << 18)

__device__ __forceinline__ unsigned xb_ld(unsigned* p)              { return __hip_atomic_load(p, __ATOMIC_RELAXED, __HIP_MEMORY_SCOPE_AGENT); }
__device__ __forceinline__ unsigned xb_add(unsigned* p, unsigned v) { return __hip_atomic_fetch_add(p, v, __ATOMIC_RELAXED, __HIP_MEMORY_SCOPE_AGENT); }
__device__ __forceinline__ unsigned xb_xcc_id() { return (unsigned)__builtin_amdgcn_s_getreg((3 << 11) | 20) & 0xFu; }
#define XB_SPIN(cond, bar) do { unsigned _sp = 0; while (cond) { __builtin_amdgcn_s_sleep(1); \
    if ((++_sp & 255u) == 0u) { if (xb_ld(&(bar)[XB_TMO])) break; if (_sp > XB_SPIN_CAP) { atomicAdd(&(bar)[XB_TMO], 1u); break; } } } } while (0)

struct XcdBarrier {
    unsigned* bar; unsigned x;
    volatile LAS unsigned* st;
};

__device__ __forceinline__ XcdBarrier xcd_barrier_post(unsigned* bar, volatile LAS unsigned* st) {
    XcdBarrier b; b.bar = bar; b.x = xb_xcc_id(); b.st = st;
    if (threadIdx.x == 0) (void)xb_add(&bar[XB_XCNT(b.x)], 1u);
    return b;
}
__device__ __forceinline__ void xcd_barrier_complete(unsigned* bar, unsigned x, unsigned& nloc, unsigned& nx) {
    const unsigned G = gridDim.x * gridDim.y * gridDim.z;
    unsigned sum, cnt, mine, sp = 0u;
    for (;;) {
        sum = 0u; cnt = 0u; mine = 0u;
#pragma unroll
        for (unsigned j = 0; j < 16; ++j) { const unsigned c = xb_ld(&bar[XB_XCNT(j)]); sum += c; cnt += (c > 0u) ? 1u : 0u; mine = (j == x) ? c : mine; }
        if (sum == G) break;
        __builtin_amdgcn_s_sleep(1);
        if ((++sp & 255u) == 0u) { if (xb_ld(&bar[XB_TMO])) break; if (sp > XB_SPIN_CAP) { atomicAdd(&bar[XB_TMO], 1u); break; } }
    }
    nloc = mine > 0u ? mine : 1u; nx = cnt > 0u ? cnt : 1u;
}

__device__ __forceinline__ void xcd_barrier(const XcdBarrier& b) {
    asm volatile("s_waitcnt vmcnt(0)" ::: "memory");
    __syncthreads();
    if (threadIdx.x == 0) {
        unsigned* bar = b.bar;
        __builtin_amdgcn_s_waitcnt(0);
        unsigned nloc = b.st[0], nx = b.st[1];
        if (nloc == 0u) { xcd_barrier_complete(bar, b.x, nloc, nx); b.st[0] = nloc; b.st[1] = nx; }
        const unsigned old = xb_add(&bar[XB_XSUB(b.x)], 1u);
        const unsigned gen = old / nloc;
        if (old + 1u == (gen + 1u) * nloc) {
            __builtin_amdgcn_fence(__ATOMIC_RELEASE, "agent");
            asm volatile("s_waitcnt vmcnt(0)" ::: "memory");
            const unsigned og = xb_add(&bar[XB_TOP], 1u);
            const unsigned tg = og / nx;
            if (og + 1u == (tg + 1u) * nx) xb_add(&bar[XB_TOPGEN], 1u);
            else XB_SPIN(xb_ld(&bar[XB_TOPGEN]) == tg, bar);
            __builtin_amdgcn_fence(__ATOMIC_ACQUIRE, "agent");
            xb_add(&bar[XB_XGEN(b.x)], 1u);
            asm volatile("s_waitcnt vmcnt(0)" ::: "memory");
        } else {
            XB_SPIN(xb_ld(&bar[XB_XGEN(b.x)]) == gen, bar);
            __builtin_amdgcn_fence(__ATOMIC_ACQUIRE, "agent");
            asm volatile("s_waitcnt vmcnt(0)" ::: "memory");
        }
    }
    __syncthreads();
}

constexpr int NWAVES = 8, NT = 512;
constexpr int BATCH = 4, SEQ = 4096, DM = 1024, M = BATCH * SEQ;
constexpr int NPROJ = 3088, NPROJ_PAD = 3328, PROJ_LD = 3072, NMIX = 1536, NQ = 2048;
constexpr int NBC = M / 128;
constexpr float EPS = 1e-6f;
typedef float f32x16 __attribute__((ext_vector_type(16)));
typedef unsigned v2u __attribute__((ext_vector_type(2)));

constexpr size_t MiB = 1u << 20;
constexpr size_t WS_CTL = 0, CTL_ZERO_BYTES = 64 * 1024;
constexpr size_t WS_MOD = 1 * MiB, WS_KEYS = 2 * MiB, WS_CD = 3 * MiB;
constexpr size_t WS_WIN = 4 * MiB, WS_WOUT = 17 * MiB, WS_WQ = 23 * MiB;
constexpr size_t WS_PART = 32 * MiB, WS_ENT = 96 * MiB, WS_GS = 104 * MiB, WS_OFF = 112 * MiB, WS_STREAM = 113 * MiB, WS_LIST = 121 * MiB;
constexpr size_t WS_XN = 160 * MiB;
constexpr size_t WS_PROJ = 208 * MiB;
constexpr size_t WS_ST = 304 * MiB;
constexpr size_t WS_X2 = 336 * MiB;
constexpr size_t WS_CBC = 400 * MiB;
constexpr size_t WS_XBT = 416 * MiB;
constexpr size_t WS_WF = 456 * MiB;
constexpr size_t WS_DTRAW = 460 * MiB, WS_DTV = 461 * MiB, WS_ACS = 462 * MiB, WS_SSQ = 463 * MiB;
constexpr size_t WS_IDX = 464 * MiB, WS_GATE = 472 * MiB;
constexpr size_t WS_END = 480 * MiB;
constexpr int CW_BAR = 1024;
static_assert((CW_BAR + XCD_BAR_WORDS) * 4 <= (int)CTL_ZERO_BYTES, "ctl");

constexpr int RING_BYTES = 131072, LDS_BYTES = 163840, LDSCTL_OFF = LDS_BYTES - 512, MISC_OFF = LDSCTL_OFF + 320;

__device__ __forceinline__ float bflo(unsigned w) { return __uint_as_float(w << 16); }
__device__ __forceinline__ float bfhi(unsigned w) { return __uint_as_float(w & 0xffff0000u); }
__device__ __forceinline__ float bf2f(unsigned short h) { return __uint_as_float(((unsigned)h) << 16); }
__device__ __forceinline__ float siluf(float x) { return x / (1.f + __expf(-x)); }
__device__ __forceinline__ float wave_sum(float v) {
#pragma unroll
    for (int o = 1; o < 64; o <<= 1) v += __shfl_xor(v, o);
    return v;
}
__device__ __forceinline__ int rowoff(int reg, int h) { return (reg & 3) + 8 * (reg >> 2) + 4 * h; }
#define MFMA32(a, b, c) __builtin_amdgcn_mfma_f32_32x32x16_bf16((a), (b), (c), 0, 0, 0)
#define DPP_ADD(v, ctrl) ((v) + __int_as_float(__builtin_amdgcn_update_dpp(0, __float_as_int(v), (ctrl), 0xF, 0xF, true)))

struct Ctx { LAS unsigned char* lds; int tid, lane, wave, G, bid; };
__device__ __forceinline__ Ctx fresh(const Ctx& X) { Ctx Y; Y.lds = X.lds; int t = X.tid; asm volatile("" : "+v"(t)); int g = X.G, b = X.bid; asm volatile("" : "+s"(g), "+s"(b)); Y.tid = t; Y.lane = t & 63; Y.wave = __builtin_amdgcn_readfirstlane(t >> 6); Y.G = g; Y.bid = b; return Y; }

__device__ __forceinline__ void p0_mod(const Ctx& X, const float* c, const float* w_ada, const float* b_ada, float* MOD) {
    LAS float* cs = (LAS float*)X.lds; LAS float* red = (LAS float*)(X.lds + 16384);
    for (int i = X.tid; i < 4096; i += NT) cs[i] = siluf(c[i]);
    __syncthreads();
    for (int item = X.bid; item < 192; item += X.G) {
        const int l = item / 96, cc = item % 96, col = cc * 64 + X.lane;
        const float* W = w_ada + (size_t)l * 1024 * 6144 + col;
        float a0 = 0.f, a1 = 0.f, a2 = 0.f, a3 = 0.f;
#pragma unroll 8
        for (int kk = 0; kk < 128; ++kk) { const int k = X.wave * 128 + kk; const float w = W[(size_t)k * 6144];
            a0 += cs[k] * w; a1 += cs[1024 + k] * w; a2 += cs[2048 + k] * w; a3 += cs[3072 + k] * w; }
        red[(X.wave * 4 + 0) * 64 + X.lane] = a0; red[(X.wave * 4 + 1) * 64 + X.lane] = a1; red[(X.wave * 4 + 2) * 64 + X.lane] = a2; red[(X.wave * 4 + 3) * 64 + X.lane] = a3;
        __syncthreads();
        if (X.tid < 256) { const int b = X.tid >> 6, ln = X.tid & 63; float s = 0.f;
#pragma unroll
            for (int w = 0; w < 8; ++w) s += red[(w * 4 + b) * 64 + ln];
            MOD[((size_t)l * 4 + b) * 6144 + cc * 64 + ln] = s + b_ada[(size_t)l * 6144 + cc * 64 + ln]; }
        __syncthreads();
    }
}
__device__ __forceinline__ void p0_fold(const Ctx& X, const float* w_in, const float* pool_w, float* WF) {
    const int gt = X.bid * NT + X.tid, GT = X.G * NT;
    for (int o = gt; o < 2 * 1024 * 512; o += GT) {
        const int n = o & 511, k = (o >> 9) & 1023, l = o >> 19, g = n >> 7, d = n & 127;
        const float* wi = w_in + ((size_t)l * 1024 + k) * NPROJ + g * 128;
        const float* pw = pool_w + ((size_t)(l * 4 + g) * 128) * 128 + d;
        float s = 0.f;
#pragma unroll 8
        for (int c = 0; c < 128; ++c) s += wi[c] * pw[(size_t)c * 128];
        WF[o] = s;
    }
}
__device__ __forceinline__ void p0_cvt(const Ctx& X, const float* src, bf16* dst, size_t n8) {
    const size_t gt = (size_t)X.bid * NT + X.tid, GT = (size_t)X.G * NT;
    for (size_t i = gt; i < n8; i += GT) {
        const f32x4 a = ((const f32x4*)src)[2 * i], b = ((const f32x4*)src)[2 * i + 1];
        v4u o; o.x = pk2(a.x, a.y); o.y = pk2(a.z, a.w); o.z = pk2(b.x, b.y); o.w = pk2(b.z, b.w);
        ((v4u*)dst)[i] = o;
    }
}
__device__ __forceinline__ void tr_item(const float* W, int ldw, int nvalid, int K, bf16* WT, LAS float* scr, int kb, int n_src0, int n_dst0, int lane) {
    const int k0 = 64 * kb;
#pragma unroll 8
    for (int i = 0; i < 32; ++i) { const int kk = 2 * i + (lane >> 5); const int n = n_src0 + (lane & 31);
        scr[kk * 33 + (lane & 31)] = (n < nvalid) ? W[(size_t)(k0 + kk) * ldw + n] : 0.f; }
    LDS_WAIT(); asm volatile("" ::: "memory");
    const int c = lane & 7;
#pragma unroll
    for (int j = 0; j < 4; ++j) { const int n = (lane >> 3) + 8 * j; const LAS float* s = scr + (8 * c) * 33 + n;
        v4u o; o.x = pk2(s[0 * 33], s[1 * 33]); o.y = pk2(s[2 * 33], s[3 * 33]); o.z = pk2(s[4 * 33], s[5 * 33]); o.w = pk2(s[6 * 33], s[7 * 33]);
        *(v4u*)(WT + (size_t)(n_dst0 + n) * K + k0 + 8 * c) = o; }
    LDS_WAIT(); asm volatile("" ::: "memory");
}
__device__ __forceinline__ void p0_transposes(const Ctx& X, const float* w_in, const float* WF, const float* w_out, const float* w_query, bf16* WIN, bf16* WOUT, bf16* WQ) {
    LAS float* scr = (LAS float*)(X.lds + X.wave * 16384);
    const int gw = X.bid * NWAVES + X.wave, NGW = X.G * NWAVES;
    constexpr int I_IN = 16 * 104, I_OUT = 24 * 32, I_Q = 16 * 64, I_L = I_IN + I_OUT + I_Q;
    for (int it = gw; it < 2 * I_L; it += NGW) {
        const int l = it / I_L; int r = it % I_L;
        if (r < I_IN) { const int kb = r / 104, nb = r % 104;
            if (nb < 16) tr_item(WF + (size_t)l * 1024 * 512, 512, 512, 1024, WIN + (size_t)l * NPROJ_PAD * 1024, scr, kb, nb * 32, nb * 32, X.lane);
            else tr_item(w_in + (size_t)l * 1024 * NPROJ, NPROJ, NPROJ, 1024, WIN + (size_t)l * NPROJ_PAD * 1024, scr, kb, nb * 32, nb * 32, X.lane);
            continue; }
        r -= I_IN;
        if (r < I_OUT) { const int kb = r / 32, nb = r % 32; tr_item(w_out + (size_t)l * NMIX * 1024, 1024, 1024, NMIX, WOUT + (size_t)l * 1024 * NMIX, scr, kb, nb * 32, nb * 32, X.lane); continue; }
        r -= I_OUT;
        { const int kb = r / 64, nb = r % 64; tr_item(w_query + (size_t)l * 1024 * NQ, NQ, NQ, 1024, WQ + (size_t)l * NQ * 1024, scr, kb, nb * 32, nb * 32, X.lane); }
    }
}
__device__ __forceinline__ void norm_mod_phase(const Ctx& X, const float* xin, const float* g, const float* shift, const float* scale, bf16* XN) {
    const int gw = X.bid * NWAVES + X.wave, NGW = X.G * NWAVES;
    for (int m = gw; m < M; m += NGW) {
        const int b = m >> 12;
        const f32x4* xr = (const f32x4*)(xin + (size_t)m * DM) + X.lane;
        f32x4 v[4]; float s = 0.f;
#pragma unroll
        for (int j = 0; j < 4; ++j) { v[j] = xr[64 * j]; s += (v[j].x * v[j].x + v[j].y * v[j].y) + (v[j].z * v[j].z + v[j].w * v[j].w); }
        const float rstd = 1.0f / sqrtf(wave_sum(s) * (1.f / DM) + EPS);
        unsigned long long* o8 = (unsigned long long*)(XN + (size_t)m * DM) + X.lane;
#pragma unroll
        for (int j = 0; j < 4; ++j) { const int col = 256 * j + 4 * X.lane;
            const f32x4 gv = *(const f32x4*)(g + col), sc = *(const f32x4*)(scale + (size_t)b * 6144 + col), sh = *(const f32x4*)(shift + (size_t)b * 6144 + col);
            const f32x4 o = (v[j] * rstd) * gv * (sc + 1.0f) + sh;
            o8[64 * j] = (unsigned long long)pk2(o.x, o.y) | ((unsigned long long)pk2(o.z, o.w) << 32); }
    }
}
__device__ __forceinline__ void ssd_a_phase(const Ctx& X, unsigned char* ws, const float* conv_w, const float* conv_b, const float* dt_bias, const float* a_log) {
#define PROJ ((const bf16*)(ws + WS_PROJ))
#define DTRAW ((const float*)(ws + WS_DTRAW))
#define CBC ((bf16*)(ws + WS_CBC))
#define XBT ((bf16*)(ws + WS_XBT))
#define DTV ((float*)(ws + WS_DTV))
#define ACS ((float*)(ws + WS_ACS))
#define CD ((float*)(ws + WS_CD))
#define ST ((bf16*)(ws + WS_ST))
    LAS unsigned char* raw = X.lds;
    LAS unsigned char* BT = X.lds + 67648;
    LAS unsigned char* XTL = X.lds + 102464;
    LAS float* dts = (LAS float*)(X.lds + 119872); LAS float* acsL = dts + 1024; LAS float* wl = dts + 2048;
    const int r_ = X.lane & 31, h = X.lane >> 5;
    for (int u = X.bid; u < NBC * 2; u += X.G) {
        const int bc = u >> 1, g = u & 1, c = bc & 31, t0 = bc * 128;
        {
            v4u rv[9];
#pragma unroll
            for (int k = 0; k < 9; ++k) { const int i = X.tid + k * NT; const int r = (i >> 5) < 131 ? (i >> 5) : 130, ck = i & 31; const int pos = c * 128 + r - 3;
                const int tr = pos >= 0 ? t0 + r - 3 : t0; const int col = (ck < 16 ? 2560 + g * 128 : 2816 + g * 128 - 128) + ck * 8;
                rv[k] = *(const v4u*)(PROJ + (size_t)tr * PROJ_LD + col); if (pos < 0) rv[k] = (v4u){0u, 0u, 0u, 0u}; }
#pragma unroll
            for (int k = 0; k < 9; ++k) { const int i = X.tid + k * NT; const int r = i >> 5, ck = i & 31;
                if (r < 131) { LAS unsigned* d = (LAS unsigned*)(raw + r * 516 + ck * 16); d[0] = rv[k].x; d[1] = rv[k].y; d[2] = rv[k].z; d[3] = rv[k].w; } }
        }
#pragma unroll
        for (int k = 0; k < 2; ++k) { const int i = X.tid + k * NT, r = i >> 7, l = i & 127, hh = g * 8 + r;
            const float x = DTRAW[(size_t)(t0 + l) * 16 + hh] + dt_bias[hh]; const float ex = __expf(x);
            const float dt = x > 20.f ? x : (ex < 0.015625f ? ex * (1.f - ex * (0.5f - ex * 0.33333333f)) : __logf(1.f + ex));
            dts[i] = dt; wl[i] = -dt * __expf(a_log[hh]); }
        __syncthreads();
        {
            const int cp = X.tid & 127, lr = X.tid >> 7, ch = 2 * cp, chx = (ch < 128 ? 1024 + g * 128 + ch : 1280 + g * 128 + ch - 128);
            float w0[4], w1[4];
#pragma unroll
            for (int j = 0; j < 4; ++j) { w0[j] = conv_w[j * 1536 + chx]; w1[j] = conv_w[j * 1536 + chx + 1]; }
            const float b0 = conv_b[chx], b1 = conv_b[chx + 1];
            bf16* dst = CBC + (size_t)t0 * 512 + (ch < 128 ? g * 128 + ch : 256 + g * 128 + ch - 128);
            for (int l = 32 * lr; l < 32 * lr + 32; ++l) { float a0 = b0, a1 = b1;
#pragma unroll
                for (int j = 0; j < 4; ++j) { const unsigned w = *(LAS unsigned*)(raw + (l + j) * 516 + cp * 4); a0 += w0[j] * bflo(w); a1 += w1[j] * bfhi(w); }
                *(unsigned*)(dst + (size_t)l * 512) = pk2(siluf(a0), siluf(a1)); }
        }
        {
            const int l = X.tid & 127, cr = X.tid >> 7;
            for (int ci = 0; ci < 32; ++ci) { const int ch = cr * 32 + ci, chx = 1024 + g * 128 + ch;
                float a = conv_b[chx];
#pragma unroll
                for (int j = 0; j < 4; ++j) a += conv_w[j * 1536 + chx] * bf2f(*(LAS unsigned short*)(raw + (l + j) * 516 + ch * 2));
                *(LAS unsigned short*)(BT + ch * 272 + l * 2) = (unsigned short)f2bf(siluf(a)); }
        }
        {
#pragma unroll
            for (int k = 0; k < 2; ++k) { const int i = X.tid + k * NT; float v = wl[i];
#pragma unroll
                for (int o = 1; o < 64; o <<= 1) { const float up = __shfl_up(v, o); if (X.lane >= o) v += up; }
                acsL[i] = v; }
        }
        __syncthreads();
#pragma unroll
        for (int k = 0; k < 2; ++k) { const int i = X.tid + k * NT; if (i & 64) acsL[i] += acsL[(i & ~127) + 63]; }
        __syncthreads();
#pragma unroll
        for (int k = 0; k < 2; ++k) { const int i = X.tid + k * NT, r = i >> 7, l = i & 127, hh = g * 8 + r; const float tot = acsL[(i & ~127) + 127], a = acsL[i];
            wl[i] = __expf(tot - a) * dts[i];
            DTV[(size_t)(bc * 16 + hh) * 128 + l] = dts[i]; ACS[(size_t)(bc * 16 + hh) * 128 + l] = a; if (l == 0) CD[bc * 16 + hh] = __expf(tot); }
        v4u xv[3];
#define SA_XLOAD(hh_) { _Pragma("unroll") for (int k = 0; k < 3; ++k) { const int i = X.tid + k * NT; const int r = (i >> 3) < 131 ? (i >> 3) : 130, ck = i & 7; const int pos = c * 128 + r - 3; \
            const int tr = pos >= 0 ? t0 + r - 3 : t0; xv[k] = *(const v4u*)(PROJ + (size_t)tr * PROJ_LD + 1536 + (hh_) * 64 + ck * 8); if (pos < 0) xv[k] = (v4u){0u, 0u, 0u, 0u}; } }
        SA_XLOAD(g * 8)
        __syncthreads();
#pragma unroll 1
        for (int r = 0; r < 8; ++r) {
            const int hh = g * 8 + r;
#pragma unroll
            for (int k = 0; k < 3; ++k) { const int i = X.tid + k * NT; const int rr = i >> 3, ck = i & 7;
                if (rr < 131) { LAS unsigned* d = (LAS unsigned*)(raw + rr * 132 + ck * 16); d[0] = xv[k].x; d[1] = xv[k].y; d[2] = xv[k].z; d[3] = xv[k].w; } }
            __syncthreads();
            if (r < 7) SA_XLOAD(hh + 1)
            {
                const int l = X.tid & 127, cq = X.tid >> 7;
                for (int ci = 0; ci < 16; ++ci) { const int p = cq * 16 + ci, chx = hh * 64 + p;
                    float a = conv_b[chx];
#pragma unroll
                    for (int j = 0; j < 4; ++j) a += conv_w[j * 1536 + chx] * bf2f(*(LAS unsigned short*)(raw + (l + j) * 132 + p * 2));
                    const unsigned short o = (unsigned short)f2bf(siluf(a));
                    *(LAS unsigned short*)(XTL + p * 272 + l * 2) = o; XBT[((size_t)bc * 1024 + chx) * 128 + l] = o; }
            }
            __syncthreads();
            {
                const int pb = X.wave & 1, nb = X.wave >> 1;
                const LAS unsigned char* xrow = XTL + (32 * pb + r_) * 272; const LAS unsigned char* brow = BT + (32 * nb + r_) * 272; const LAS float* wr = wl + r * 128;
                f32x16 acc;
#pragma unroll
                for (int i = 0; i < 16; ++i) acc[i] = 0.f;
#pragma unroll
                for (int ks = 0; ks < 8; ++ks) { const int k0 = 16 * ks + 8 * h;
                    const v4u xa = *(const LAS v4u*)(xrow + k0 * 2); const bf16x8 bb = *(const LAS bf16x8*)(brow + k0 * 2);
                    v4u sa; sa.x = pk2(bflo(xa.x) * wr[k0 + 0], bfhi(xa.x) * wr[k0 + 1]); sa.y = pk2(bflo(xa.y) * wr[k0 + 2], bfhi(xa.y) * wr[k0 + 3]);
                    sa.z = pk2(bflo(xa.z) * wr[k0 + 4], bfhi(xa.z) * wr[k0 + 5]); sa.w = pk2(bflo(xa.w) * wr[k0 + 6], bfhi(xa.w) * wr[k0 + 7]);
                    acc = MFMA32(__builtin_bit_cast(bf16x8, sa), bb, acc); }
                bf16* so = ST + ((size_t)(bc * 16 + hh) * 64) * 128;
#pragma unroll
                for (int i = 0; i < 16; ++i) { const int p = 32 * pb + rowoff(i, h); so[(size_t)p * 128 + 32 * nb + r_] = (bf16)f2bf(acc[i]); }
            }
            __syncthreads();
        }
#undef SA_XLOAD
    }
#undef PROJ
#undef DTRAW
#undef CBC
#undef XBT
#undef DTV
#undef ACS
#undef CD
#undef ST
}
__device__ __forceinline__ void ssd_scan_phase(const Ctx& X, bf16* ST, const float* CD) {
    const int gt = X.bid * NT + X.tid, GT = X.G * NT;
    for (int e = gt; e < 131072; e += GT) {
        const int n4 = e & 31, p = (e >> 5) & 63, hh = (e >> 11) & 15, b = e >> 15;
        bf16* base = ST + ((size_t)((b * 32) * 16 + hh) * 64 + p) * 128 + n4 * 4;
        v2u st[32];
#pragma unroll
        for (int c = 0; c < 32; ++c) st[c] = *(const v2u*)(base + (size_t)c * 131072);
        float h0 = 0.f, h1 = 0.f, h2 = 0.f, h3 = 0.f;
#pragma unroll
        for (int c = 0; c < 32; ++c) { const float cd = CD[(b * 32 + c) * 16 + hh];
            v2u o; o.x = pk2(h0, h1); o.y = pk2(h2, h3); *(v2u*)(base + (size_t)c * 131072) = o;
            h0 = h0 * cd + bflo(st[c].x); h1 = h1 * cd + bfhi(st[c].x); h2 = h2 * cd + bflo(st[c].y); h3 = h3 * cd + bfhi(st[c].y); }
    }
}
__device__ __forceinline__ void ssd_c_phase(const Ctx& X, unsigned char* ws, const float* d_skip) {
#define PROJ ((const bf16*)(ws + WS_PROJ))
#define CBC ((const bf16*)(ws + WS_CBC))
#define XBT ((const bf16*)(ws + WS_XBT))
#define DTV ((const float*)(ws + WS_DTV))
#define ACS ((const float*)(ws + WS_ACS))
#define ST ((const bf16*)(ws + WS_ST))
#define YA ((bf16*)(ws + WS_XN))
#define SSQ ((float*)(ws + WS_SSQ))
    LAS unsigned char* CT = X.lds;
    LAS unsigned char* BK = X.lds + 34816;
    LAS unsigned char* XTL = BK; LAS unsigned char* HPL = BK + 17408;
    LAS unsigned char* ML = X.lds + 69632;
    LAS float* acsL = (LAS float*)(X.lds + 104448); LAS float* dtL = acsL + 1024; LAS float* eaL = acsL + 2048; LAS float* ssqL = acsL + 3072;
    const int r_ = X.lane & 31, h = X.lane >> 5;
    for (int u = X.bid; u < NBC * 2; u += X.G) {
        const int bc = u >> 1, g = u & 1, t0 = bc * 128;
        {
            v4u cv[4], bv[4];
#pragma unroll
            for (int k = 0; k < 4; ++k) { const int i = X.tid + k * NT, row = i >> 4, ck = i & 15;
                cv[k] = *(const v4u*)(CBC + (size_t)(t0 + row) * 512 + 256 + g * 128 + ck * 8); bv[k] = *(const v4u*)(CBC + (size_t)(t0 + row) * 512 + g * 128 + ck * 8); }
            float av[2], dv[2];
#pragma unroll
            for (int k = 0; k < 2; ++k) { const int i = X.tid + k * NT; av[k] = ACS[(size_t)(bc * 16 + g * 8) * 128 + i]; dv[k] = DTV[(size_t)(bc * 16 + g * 8) * 128 + i]; }
#pragma unroll
            for (int k = 0; k < 4; ++k) { const int i = X.tid + k * NT, row = i >> 4, ck = i & 15; *(LAS v4u*)(CT + row * 272 + ck * 16) = cv[k]; *(LAS v4u*)(BK + row * 272 + ck * 16) = bv[k]; }
#pragma unroll
            for (int k = 0; k < 2; ++k) { const int i = X.tid + k * NT; acsL[i] = av[k]; dtL[i] = dv[k]; eaL[i] = __expf(av[k]); }
        }
        v4u xr[2], hr[2];
#define SC_XHLOAD(hh_) { _Pragma("unroll") for (int k = 0; k < 2; ++k) { const int i = X.tid + k * NT; \
            xr[k] = *(const v4u*)(XBT + ((size_t)bc * 1024 + (hh_) * 64) * 128 + (size_t)i * 8); hr[k] = *(const v4u*)(ST + ((size_t)(bc * 16 + (hh_)) * 64) * 128 + (size_t)i * 8); } }
        SC_XHLOAD(g * 8)
        __syncthreads();
        f32x16 cb[2];
        const int lb = X.wave >> 1, sh = X.wave & 1;
#pragma unroll
        for (int j = 0; j < 2; ++j) { const int sb = 2 * sh + j;
#pragma unroll
            for (int i = 0; i < 16; ++i) cb[j][i] = 0.f;
            if (sb <= lb) {
                const LAS unsigned char* crow = CT + (32 * lb + r_) * 272; const LAS unsigned char* brow = BK + (32 * sb + r_) * 272;
#pragma unroll
                for (int ks = 0; ks < 8; ++ks) { const int k0 = 16 * ks + 8 * h; cb[j] = MFMA32(*(const LAS bf16x8*)(crow + k0 * 2), *(const LAS bf16x8*)(brow + k0 * 2), cb[j]); }
            }
        }
        __syncthreads();
#pragma unroll 1
        for (int r = 0; r < 8; ++r) {
            const int hh = g * 8 + r; const LAS float* ac = acsL + r * 128; const LAS float* dl = dtL + r * 128; const LAS float* ea = eaL + r * 128;
#pragma unroll
            for (int k = 0; k < 2; ++k) { const int i = X.tid + k * NT, row = i >> 4, ck = i & 15; *(LAS v4u*)(XTL + row * 272 + ck * 16) = xr[k]; *(LAS v4u*)(HPL + row * 272 + ck * 16) = hr[k]; }
#pragma unroll
            for (int j = 0; j < 2; ++j) { const int sb = 2 * sh + j;
                if (sb <= lb) { const int s_ = 32 * sb + r_; const float as = ac[s_], ds = dl[s_];
#pragma unroll
                    for (int i = 0; i < 16; ++i) { const int l = 32 * lb + rowoff(i, h); const float vv = cb[j][i] * __expf(ac[l] - as) * ds; const unsigned msk = (unsigned)((l - s_) >> 31);
                        *(LAS unsigned short*)(ML + l * 272 + s_ * 2) = (unsigned short)f2bf(__uint_as_float(__float_as_uint(vv) & ~msk));
                        if ((i & 3) == 3) __builtin_amdgcn_sched_barrier(0); } }
            }
            __syncthreads();
            if (r < 7) SC_XHLOAD(hh + 1)
            {
                const int lb2 = X.wave >> 1, pb = X.wave & 1, p = 32 * pb + r_;
                unsigned short zv[16];
                const char* zb = (const char*)PROJ + ((size_t)(t0 + 32 * lb2) * PROJ_LD + 512 + hh * 64) * 2; const unsigned zo = (unsigned)(4 * h * PROJ_LD + p) * 2u;
#pragma unroll
                for (int i = 0; i < 16; ++i) zv[i] = *(const unsigned short*)(zb + (size_t)((i & 3) + 8 * (i >> 2)) * PROJ_LD * 2 + zo);
                f32x16 accd, acco;
#pragma unroll
                for (int i = 0; i < 16; ++i) { accd[i] = 0.f; acco[i] = 0.f; }
                const LAS unsigned char* mrow = ML + (32 * lb2 + r_) * 272; const LAS unsigned char* xrow = XTL + p * 272;
                for (int ks = 0; ks < 2 * (lb2 + 1); ++ks) { const int k0 = 16 * ks + 8 * h; accd = MFMA32(*(const LAS bf16x8*)(mrow + k0 * 2), *(const LAS bf16x8*)(xrow + k0 * 2), accd); }
                const LAS unsigned char* crow = CT + (32 * lb2 + r_) * 272; const LAS unsigned char* hrow = HPL + p * 272;
#pragma unroll 4
                for (int ks = 0; ks < 8; ++ks) { const int k0 = 16 * ks + 8 * h; acco = MFMA32(*(const LAS bf16x8*)(crow + k0 * 2), *(const LAS bf16x8*)(hrow + k0 * 2), acco); }
                const float dsk = d_skip[hh];
                char* yb = (char*)YA + ((size_t)(t0 + 32 * lb2) * NMIX + 512 + hh * 64) * 2; const unsigned yo = (unsigned)(4 * h * NMIX + p) * 2u;
#pragma unroll
                for (int i = 0; i < 16; ++i) { const int l = 32 * lb2 + rowoff(i, h);
                    float y = accd[i] + ea[l] * acco[i];
                    y += dsk * bf2f(*(const LAS unsigned short*)(xrow + l * 2));
                    const float yg = y * siluf(bf2f(zv[i]));
                    *(unsigned short*)(yb + (size_t)((i & 3) + 8 * (i >> 2)) * NMIX * 2 + yo) = (unsigned short)f2bf(yg);
                    float q = yg * yg;
                    q = DPP_ADD(q, 0xB1); q = DPP_ADD(q, 0x4E); q = DPP_ADD(q, 0x141); q = DPP_ADD(q, 0x140); q += __shfl_xor(q, 16);
                    if (r_ == 0) ssqL[l * 2 + pb] = q;
                    if ((i & 3) == 3) __builtin_amdgcn_sched_barrier(0); }
            }
            __syncthreads();
            if (X.tid < 128) SSQ[(size_t)(t0 + X.tid) * 16 + hh] = ssqL[X.tid * 2] + ssqL[X.tid * 2 + 1];
            __syncthreads();
        }
#undef SC_XHLOAD
    }
#undef PROJ
#undef CBC
#undef XBT
#undef DTV
#undef ACS
#undef ST
#undef YA
#undef SSQ
}
__device__ __forceinline__ void mix_finish_phase(const Ctx& X, const bf16* PROJ, const float* SSQ, const float* ssd_norm, const float* pool_b, const float* pool_scale, bf16* YA) {
    for (int rb = X.bid; rb < M / 64; rb += X.G) {
        for (int i = 0; i < 8; ++i) {
            const int t = rb * 64 + X.wave * 8 + i, pos = t & 4095;
            float q = (X.lane < 16) ? SSQ[(size_t)t * 16 + X.lane] : 0.f; q = wave_sum(q);
            const float rstd = 1.0f / sqrtf(q * (1.f / 1024.f) + EPS);
#pragma unroll
            for (int hf = 0; hf < 2; ++hf) { const int ch = hf * 512 + 8 * X.lane; bf16* yp = YA + (size_t)t * NMIX + 512 + ch;
                const v4u v = *(const v4u*)yp; const f32x4 g0 = *(const f32x4*)(ssd_norm + ch), g1 = *(const f32x4*)(ssd_norm + ch + 4);
                v4u o; o.x = pk2(bflo(v.x) * rstd * g0.x, bfhi(v.x) * rstd * g0.y); o.y = pk2(bflo(v.y) * rstd * g0.z, bfhi(v.y) * rstd * g0.w);
                o.z = pk2(bflo(v.z) * rstd * g1.x, bfhi(v.z) * rstd * g1.y); o.w = pk2(bflo(v.w) * rstd * g1.z, bfhi(v.w) * rstd * g1.w);
                *(v4u*)yp = o; }
            {
                const int ch = 8 * X.lane, w = 2 << (X.lane >> 4);
                float s[8], cur[8];
#pragma unroll
                for (int e = 0; e < 8; ++e) { s[e] = 0.f; cur[e] = 0.f; }
                for (int j = 0; j < 16; ++j) {
                    if (j < w && j <= pos) { const v4u v = *(const v4u*)(PROJ + (size_t)(t - j) * PROJ_LD + ch);
                        const float f[8] = {bflo(v.x), bfhi(v.x), bflo(v.y), bfhi(v.y), bflo(v.z), bfhi(v.z), bflo(v.w), bfhi(v.w)};
#pragma unroll
                        for (int e = 0; e < 8; ++e) { s[e] += f[e]; if (j == 0) cur[e] = f[e]; } }
                }
                const float inv = 1.0f / (float)((pos + 1 < w) ? (pos + 1) : w);
                const f32x4 b0 = *(const f32x4*)(pool_b + ch), b1 = *(const f32x4*)(pool_b + ch + 4), c0 = *(const f32x4*)(pool_scale + ch), c1 = *(const f32x4*)(pool_scale + ch + 4);
                float o[8];
                o[0] = (s[0] * inv - cur[0] + b0.x) * c0.x; o[1] = (s[1] * inv - cur[1] + b0.y) * c0.y; o[2] = (s[2] * inv - cur[2] + b0.z) * c0.z; o[3] = (s[3] * inv - cur[3] + b0.w) * c0.w;
                o[4] = (s[4] * inv - cur[4] + b1.x) * c1.x; o[5] = (s[5] * inv - cur[5] + b1.y) * c1.y; o[6] = (s[6] * inv - cur[6] + b1.z) * c1.z; o[7] = (s[7] * inv - cur[7] + b1.w) * c1.w;
                v4u ov; ov.x = pk2(o[0], o[1]); ov.y = pk2(o[2], o[3]); ov.z = pk2(o[4], o[5]); ov.w = pk2(o[6], o[7]);
                *(v4u*)(YA + (size_t)t * NMIX + ch) = ov;
            }
        }
    }
}
__device__ __forceinline__ unsigned f2key(float f) { const unsigned b = __float_as_uint(f); return b ^ ((unsigned)((int)b >> 31) | 0x80000000u); }
__device__ __forceinline__ float key2f(unsigned u) { const unsigned b = (u & 0x80000000u) ? (u ^ 0x80000000u) : ~u; return __uint_as_float(b); }
#define INSK(L, kk) do { unsigned _v = (kk); _Pragma("unroll") for (int _j = 0; _j < 16; ++_j) { const unsigned _t = L[_j] > _v ? L[_j] : _v; _v = L[_j] > _v ? _v : L[_j]; L[_j] = _t; } } while (0)
__device__ __forceinline__ void route_phase(const Ctx& X, const bf16* Q, const bf16* KEYS_l, int* IDX, float* GATE) {
    LAS bf16* KL = (LAS bf16*)X.lds;
    const int r = X.lane & 31, h = X.lane >> 5;
    for (int u = X.bid; u < (M / 256) * 8; u += X.G) {
        const int tb = u >> 3, hd = u & 7;
        for (int i = X.tid; i < 4096; i += NT) { const int half = i >> 11, row = (i >> 4) & 127, ck = i & 15;
            const v4u v = *(const v4u*)(KEYS_l + ((size_t)(half * 8 + hd) * 128 + row) * 128 + ck * 8);
            *(LAS v4u*)(KL + (half * 128 + row) * 136 + ck * 8) = v; }
        __syncthreads();
        const int tok = tb * 256 + X.wave * 32 + r;
        unsigned K1[16], L[16];
#pragma unroll
        for (int half = 0; half < 2; ++half) {
            f32x16 acc[4];
#pragma unroll
            for (int mt = 0; mt < 4; ++mt)
#pragma unroll
                for (int i = 0; i < 16; ++i) acc[mt][i] = 0.f;
            const bf16* qrow = Q + (size_t)tok * NQ + hd * 256 + half * 128;
#pragma unroll
            for (int ks = 0; ks < 8; ++ks) { const int k0 = 16 * ks + 8 * h; const bf16x8 qb = *(const bf16x8*)(qrow + k0);
#pragma unroll
                for (int mt = 0; mt < 4; ++mt) acc[mt] = MFMA32(*(const LAS bf16x8*)(KL + (half * 128 + 32 * mt + r) * 136 + k0), qb, acc[mt]); }
#pragma unroll
            for (int j = 0; j < 16; ++j) L[j] = 0u;
#pragma unroll
            for (int mt = 0; mt < 4; ++mt)
#pragma unroll
                for (int i = 0; i < 16; ++i) INSK(L, (f2key(acc[mt][i]) & ~127u) | (unsigned)(32 * mt + rowoff(i, h)));
            unsigned S[16];
#pragma unroll
            for (int j = 0; j < 16; ++j) S[j] = (unsigned)__shfl_xor((int)L[j], 32);
#pragma unroll
            for (int j = 0; j < 16; ++j) INSK(L, S[j]);
            if (half == 0) {
#pragma unroll
                for (int j = 0; j < 16; ++j) K1[j] = L[j];
            }
        }
        float V1[16], V2[16];
#pragma unroll
        for (int j = 0; j < 16; ++j) { V1[j] = key2f(K1[j] & ~127u); V2[j] = key2f(L[j] & ~127u); }
        unsigned C[16];
#pragma unroll
        for (int j = 0; j < 16; ++j) C[j] = 0u;
#pragma unroll
        for (int a = 0; a < 16; ++a)
#pragma unroll
            for (int b = 0; b < 16; ++b) if ((a + 1) * (b + 1) <= 16) INSK(C, (f2key(V1[a] + V2[b]) & ~255u) | (unsigned)(a * 16 + b));
        float e[16], s = 0.f; const float top = key2f(C[0] & ~255u);
#pragma unroll
        for (int j = 0; j < 16; ++j) { e[j] = __expf(key2f(C[j] & ~255u) - top); s += e[j]; }
        const float inv = 1.0f / s;
        int* ip = IDX + (size_t)tok * 128 + hd * 16; float* gp = GATE + (size_t)tok * 128 + hd * 16;
#pragma unroll
        for (int j = 0; j < 16; ++j) {
            const unsigned a = (C[j] >> 4) & 15u, b = C[j] & 15u;
            unsigned i1 = K1[0], i2 = L[0];
#pragma unroll
            for (int q = 1; q < 16; ++q) { i1 = (a == (unsigned)q) ? K1[q] : i1; i2 = (b == (unsigned)q) ? L[q] : i2; }
            if (h == (j >> 3)) { ip[j] = (int)((i1 & 127u) * 128u + (i2 & 127u)); gp[j] = e[j] * inv; }
        }
        __syncthreads();
    }
}
__device__ __forceinline__ void peer_sort_phase(const Ctx& X, const int* IDX, const float* GATE, int* ENT, float* GS, unsigned short* OFFT) {
    LAS unsigned char* OL = X.lds;
    for (int tile = X.bid; tile < M / 64; tile += X.G) {
        for (int i = 0; i < 8; ++i) {
            const int tl = X.wave * 8 + i, t = tile * 64 + tl;
            const int e0 = IDX[(size_t)t * 128 + X.lane], e1 = IDX[(size_t)t * 128 + 64 + X.lane];
            const float g0 = GATE[(size_t)t * 128 + X.lane], g1 = GATE[(size_t)t * 128 + 64 + X.lane];
            const unsigned key0 = ((unsigned)(e0 >> 9) << 7) | (unsigned)X.lane, key1 = ((unsigned)(e1 >> 9) << 7) | (unsigned)(64 + X.lane);
            int pos0 = 0, pos1 = 0, cnt = 0;
#pragma unroll 8
            for (int j = 0; j < 64; ++j) {
                const unsigned a = (unsigned)__builtin_amdgcn_readlane((int)key0, j), b = (unsigned)__builtin_amdgcn_readlane((int)key1, j);
                pos0 += (a < key0) + (b < key0); pos1 += (a < key1) + (b < key1);
                cnt += ((a >> 7) < (unsigned)X.lane) + ((b >> 7) < (unsigned)X.lane);
            }
            ENT[(size_t)t * 128 + pos0] = e0; ENT[(size_t)t * 128 + pos1] = e1; GS[(size_t)t * 128 + pos0] = g0; GS[(size_t)t * 128 + pos1] = g1;
            if (X.lane <= 32) OL[tl * 40 + X.lane] = (unsigned char)cnt;
        }
        __syncthreads();
        for (int i = X.tid; i < 2048; i += NT) { const int c = i >> 6, tl = i & 63; const unsigned o0 = OL[tl * 40 + c], o1 = OL[tl * 40 + c + 1];
            OFFT[(size_t)c * M + tile * 64 + tl] = (unsigned short)(o0 | ((o1 - o0) << 8)); }
        __syncthreads();
    }
}
typedef __bf16 bf16x2_t __attribute__((ext_vector_type(2)));
typedef short s16x4_t __attribute__((ext_vector_type(4)));
__device__ __forceinline__ float dot2bf(unsigned a, unsigned b, float c) { return __builtin_amdgcn_fdot2_f32_bf16(__builtin_bit_cast(bf16x2_t, a), __builtin_bit_cast(bf16x2_t, b), c, false); }
__device__ __forceinline__ void down_load_ent(const int* ENT, const bf16* XN, unsigned w, int q, int rot, int s, int base, int (&ent)[4], v4u (&hv)[4]) {
    const int t = (int)(w >> 16), off0 = (int)(w & 0xffu);
    { int p = off0 + base + 4 * q; p = p < 124 ? p : 124; const v4u ev = *(const v4u*)(ENT + (size_t)t * 128 + p); const int sh = off0 + base + 4 * q - p;
      ent[0] = (int)(sh == 0 ? ev.x : (sh == 1 ? ev.y : (sh == 2 ? ev.z : ev.w))); ent[1] = (int)(sh == 0 ? ev.y : (sh == 1 ? ev.z : ev.w)); ent[2] = (int)(sh == 0 ? ev.z : ev.w); ent[3] = (int)ev.w; }
#pragma unroll
    for (int ii = 0; ii < 4; ++ii) hv[ii] = *(const v4u*)(XN + (size_t)t * DM + s * 128 + (4 * ((ii + rot) & 3) + q) * 8);
}
__device__ __forceinline__ void down_compute(LAS unsigned char* DL, float* PART, unsigned w, int s, int q, int rot, int nb, int base, const int (&ent)[4], const v4u (&hv)[4]) {
    const int t = (int)(w >> 16), off0 = (int)(w & 0xffu), n = (int)((w >> 8) & 0xffu);
    float res[4] = {0.f, 0.f, 0.f, 0.f};
    v4u dA[4], dB[4], dC[4], dD[4];
#define DOWN_ROW(i, D) { const int e_ = __builtin_amdgcn_update_dpp(0, ent[(i) & 3], (((i) >> 2) & 3) * 0x55, 0xF, 0xF, true); const LAS unsigned char* rp_ = DL + (e_ & 511) * 256 + q * 16; \
        D[0] = *(const LAS v4u*)(rp_ + ((0 + rot) & 3) * 64); D[1] = *(const LAS v4u*)(rp_ + ((1 + rot) & 3) * 64); D[2] = *(const LAS v4u*)(rp_ + ((2 + rot) & 3) * 64); D[3] = *(const LAS v4u*)(rp_ + ((3 + rot) & 3) * 64); }
#define DOWN_MATH(i, D) { f32x4 ca = {0.f, 0.f, 0.f, 0.f}, cb = {0.f, 0.f, 0.f, 0.f}; \
        _Pragma("unroll") for (int ii = 0; ii < 4; ++ii) { \
            ca = __builtin_amdgcn_mfma_f32_4x4x4bf16_1k(__builtin_bit_cast(s16x4_t, (v2u){D[ii].x, D[ii].y}), __builtin_bit_cast(s16x4_t, (v2u){hv[ii].x, hv[ii].y}), ca, 0, 0, 0); \
            cb = __builtin_amdgcn_mfma_f32_4x4x4bf16_1k(__builtin_bit_cast(s16x4_t, (v2u){D[ii].z, D[ii].w}), __builtin_bit_cast(s16x4_t, (v2u){hv[ii].z, hv[ii].w}), cb, 0, 0, 0); } \
        const f32x4 c4 = ca + cb; float acc = q == 0 ? c4[0] : (q == 1 ? c4[1] : (q == 2 ? c4[2] : c4[3]));     \
        acc = DPP_ADD(acc, 0xB1); acc = DPP_ADD(acc, 0x4E); \
        if (q == (((i) >> 2) & 3)) res[(i) & 3] = acc; }
#define DOWN_STEP2(i, Dc0, Dc1, Dn0, Dn1) { if ((i) >= nb) goto down_done; DOWN_ROW((i) + 2, Dn0) DOWN_ROW((i) + 3, Dn1) __builtin_amdgcn_sched_barrier(0); DOWN_MATH(i, Dc0) DOWN_MATH((i) + 1, Dc1) __builtin_amdgcn_sched_barrier(0); }
    DOWN_ROW(0, dA) DOWN_ROW(1, dB)
    DOWN_STEP2(0, dA, dB, dC, dD) DOWN_STEP2(2, dC, dD, dA, dB) DOWN_STEP2(4, dA, dB, dC, dD) DOWN_STEP2(6, dC, dD, dA, dB)
    DOWN_STEP2(8, dA, dB, dC, dD) DOWN_STEP2(10, dC, dD, dA, dB) DOWN_STEP2(12, dA, dB, dC, dD) DOWN_STEP2(14, dC, dD, dA, dB)
    down_done:;
#undef DOWN_STEP2
#undef DOWN_ROW
#undef DOWN_MATH
#pragma unroll
    for (int r = 0; r < 4; ++r) { const int j = base + 4 * q + r; if (j < n) PART[((size_t)s * M + t) * 128 + off0 + j] = res[r]; }
}
__device__ __forceinline__ int wave_max_i(int v) {
#pragma unroll
    for (int o = 4; o < 64; o <<= 1) { const int u = __shfl_xor(v, o); v = u > v ? u : v; }
    return __builtin_amdgcn_readfirstlane(v);
}
constexpr int LIST_STRIDE = 16384 + 64;
__device__ __forceinline__ void peer_down_phase(const Ctx& X, const float* e_down_l, const bf16* XN, const int* ENT, const unsigned short* OFFT, unsigned* LISTG, float* PART, int ghost) {
    LAS unsigned char* DL = X.lds;
    LAS unsigned* HB = (LAS unsigned*)(X.lds + 132096);
    const int q = X.lane & 3, tg = X.lane >> 2, rot = (tg >> 1) & 3;
    for (int role = X.bid; role < 256; role += X.G) {
        const int s = role & 7, c = role >> 3;
        if (X.tid < 160) HB[X.tid] = 0u;
#pragma unroll 1
        for (int i0 = X.tid; i0 < 512 * 32; i0 += NT * 8) {
            f32x4 v[8]; const char* db = (const char*)(e_down_l + (size_t)(c * 512) * DM + s * 128); const unsigned vo = (unsigned)((i0 >> 5) * DM + (i0 & 31) * 4) * 4u;
#pragma unroll
            for (int u = 0; u < 8; ++u) v[u] = *(const f32x4*)(db + (size_t)u * 16 * DM * 4 + vo);
#pragma unroll
            for (int u = 0; u < 8; ++u) { const int i = i0 + u * NT; v2u o; o.x = pk2(v[u].x, v[u].y); o.y = pk2(v[u].z, v[u].w); *(LAS v2u*)(DL + (i >> 5) * 256 + (i & 31) * 8) = o; }
        }
        __syncthreads();
        const unsigned short* oc = OFFT + (size_t)c * M; unsigned* LIST = LISTG + (size_t)role * LIST_STRIDE;
        unsigned wv[32];
#pragma unroll
        for (int u = 0; u < 32; ++u) wv[u] = oc[X.tid + u * NT];
#pragma unroll
        for (int u = 0; u < 32; ++u) { const unsigned n = wv[u] >> 8; if (n) __hip_atomic_fetch_add(HB + (n < 63u ? n : 63u), 1u, __ATOMIC_RELAXED, __HIP_MEMORY_SCOPE_WORKGROUP); }
        __syncthreads();
        if (X.tid == 0) { unsigned acc = 0u; for (int n = 63; n >= 1; --n) { HB[64 + n] = acc; acc += HB[n]; } HB[128] = acc; }
        __syncthreads();
        const int total = (int)HB[128];
#pragma unroll
        for (int u = 0; u < 32; ++u) { const unsigned n = wv[u] >> 8; if (n) { const unsigned pos = __hip_atomic_fetch_add(HB + 64 + (n < 63u ? n : 63u), 1u, __ATOMIC_RELAXED, __HIP_MEMORY_SCOPE_WORKGROUP);
            LIST[pos] = ((unsigned)(X.tid + u * NT) << 16) | wv[u]; } }
        if (X.tid < 32) LIST[total + X.tid] = 0u;
        asm volatile("s_waitcnt vmcnt(0)" ::: "memory");
        __syncthreads();
        const int nbatch = (total + 15) >> 4, lim = total + 15;
#define LWORD(bi_) ({ int ix_ = 16 * (bi_) + tg; ix_ = ix_ < lim ? ix_ : lim; LIST[ix_]; })
        unsigned wA, wB, wC; int entA[4], entB[4]; v4u hvA[4], hvB[4];
        int bi = X.wave;
        wA = LWORD(bi); wB = LWORD(bi + NWAVES); wC = LWORD(bi + 2 * NWAVES);
        down_load_ent(ENT, XN, wA, q, rot, s, 0, entA, hvA);
        down_load_ent(ENT, XN, wB, q, rot, s, 0, entB, hvB);
#pragma unroll 1
        for (; bi < nbatch; bi += NWAVES) {
            unsigned wD; int entC[4]; v4u hvC[4];
            wD = LWORD(bi + 3 * NWAVES);
            down_load_ent(ENT, XN, wC, q, rot, s, 0, entC, hvC);
            if (ghost == 1) { if (wA == 0xffffffffu) PART[wA >> 16] = __uint_as_float(hvA[0].x + hvA[1].y + hvA[2].z + hvA[3].w + entA[0] + entA[1] + entA[2] + entA[3]); }
            else {
                const int nb = wave_max_i((int)((wA >> 8) & 0xffu));
                down_compute(DL, PART, wA, s, q, rot, nb, 0, entA, hvA);
                for (int base = 16; base < nb; base += 16) {
                    int entX[4]; v4u hvX[4]; down_load_ent(ENT, XN, wA, q, rot, s, base, entX, hvX);
                    down_compute(DL, PART, wA, s, q, rot, nb - base, base, entX, hvA);
                }
            }
            wA = wB; wB = wC; wC = wD;
#pragma unroll
            for (int r = 0; r < 4; ++r) { entA[r] = entB[r]; hvA[r] = hvB[r]; entB[r] = entC[r]; hvB[r] = hvC[r]; }
        }
#undef LWORD
        __syncthreads();
    }
}
__device__ __forceinline__ float gelu_erf(float x) { return 0.5f * x * (1.0f + erff(x * 0.70710678118654752f)); }
__device__ __forceinline__ void peer_combine_phase(const Ctx& X, const float* PART, const float* GS, const int* ENT, unsigned* STREAM) {
    LAS unsigned* T = (LAS unsigned*)X.lds;
    for (int tile = X.bid; tile < M / 64; tile += X.G) {
        for (int i = X.tid; i < 8192; i += NT) { const int tl = i >> 7, pos = i & 127; const size_t idx = (size_t)(tile * 64 + tl) * 128 + pos;
            float a = 0.f;
#pragma unroll
            for (int s = 0; s < 8; ++s) a += PART[(size_t)s * M * 128 + idx];
            const float cf = GS[idx] * gelu_erf(a);
            T[pos * 65 + tl] = ((unsigned)ENT[idx] << 16) | f2bf(cf); }
        __syncthreads();
        for (int i = X.tid; i < 2048; i += NT) { const int p4 = i >> 6, tl = i & 63; v4u o; o.x = T[(4 * p4 + 0) * 65 + tl]; o.y = T[(4 * p4 + 1) * 65 + tl]; o.z = T[(4 * p4 + 2) * 65 + tl]; o.w = T[(4 * p4 + 3) * 65 + tl];
            ((v4u*)STREAM)[(size_t)(tile * 32 + p4) * 64 + tl] = o; }
        __syncthreads();
    }
}
#define UP_WORD(w) { const float cf = __uint_as_float((w) << 16); const v2u u = *(const LAS v2u*)(UL + (((w) >> 13) & 0x7fff8u)); \
        a0 += cf * bflo(u.x); a1 += cf * bfhi(u.x); a2 += cf * bflo(u.y); a3 += cf * bfhi(u.y); }
#define UP_BLOCK(wv) { _Pragma("unroll") for (int u_ = 0; u_ < 8; ++u_) { UP_WORD(wv[u_].x) UP_WORD(wv[u_].y) UP_WORD(wv[u_].z) UP_WORD(wv[u_].w) } }
#define UP_LOAD(wv, g_) { const int g2_ = (g_) < 128 ? (g_) : 127; const unsigned vo_ = (unsigned)((((X.wave + NWAVES * (g2_ >> 2) + trot) & 255) * 32 + (g2_ & 3) * 8) * 64 + X.lane) * 16u; \
        _Pragma("unroll") for (int u_ = 0; u_ < 8; ++u_) wv[u_] = *(const v4u*)(sbase + vo_ + u_ * 1024); }
#define UP_FINISH(g_) { if (((g_) & 3) == 3) { const int t = ((X.wave + NWAVES * ((g_) >> 2) + trot) & 255) * 64 + X.lane, b = t >> 12; \
        const f32x4 xv = *(const f32x4*)(x1 + (size_t)t * DM + cg * 4), gv = *(const f32x4*)(gate_f + (size_t)b * 6144 + cg * 4); \
        f32x4 o; o.x = xv.x + gv.x * a0; o.y = xv.y + gv.y * a1; o.z = xv.z + gv.z * a2; o.w = xv.w + gv.w * a3; \
        *(f32x4*)(x2 + (size_t)t * DM + cg * 4) = o; a0 = 0.f; a1 = 0.f; a2 = 0.f; a3 = 0.f; } }
__device__ __forceinline__ void peer_up_phase(const Ctx& X, const float* e_up_l, const unsigned* STREAM, const float* x1, const float* gate_f, float* x2) {
    LAS unsigned char* UL = X.lds;
    const char* sbase = (const char*)STREAM;
    for (int role = X.bid; role < 256; role += X.G) {
        const int cg = (role & 7) * 32 + (role >> 3), trot = (role >> 3);
#pragma unroll 1
        for (int e0 = X.tid; e0 < 16384; e0 += NT * 8) {
            f32x4 v[8]; const unsigned vo = (unsigned)(e0 * DM + cg * 4) * 4u;
#pragma unroll
            for (int u = 0; u < 8; ++u) v[u] = *(const f32x4*)((const char*)e_up_l + (size_t)u * NT * DM * 4 + vo);
#pragma unroll
            for (int u = 0; u < 8; ++u) { v2u o; o.x = pk2(v[u].x, v[u].y); o.y = pk2(v[u].z, v[u].w); *(LAS v2u*)(UL + (e0 + u * NT) * 8) = o; }
        }
        __syncthreads();
        float a0 = 0.f, a1 = 0.f, a2 = 0.f, a3 = 0.f;
        v4u wa[8], wb[8];
        UP_LOAD(wa, 0)
#pragma unroll 1
        for (int g = 0; g < 128; g += 2) {
            UP_LOAD(wb, g + 1)
            UP_BLOCK(wa) UP_FINISH(g)
            UP_LOAD(wa, g + 2)
            UP_BLOCK(wb) UP_FINISH(g + 1)
        }
        __syncthreads();
    }
}
#undef UP_WORD
#undef UP_BLOCK
#undef UP_LOAD
#undef UP_FINISH
__device__ __forceinline__ void final_norm_phase(const Ctx& X, const float* xin, const float* g, float* out) {
    const int gw = X.bid * NWAVES + X.wave, NGW = X.G * NWAVES;
    for (int m = gw; m < M; m += NGW) {
        const f32x4* xr = (const f32x4*)(xin + (size_t)m * DM) + X.lane;
        f32x4 v[4]; float s = 0.f;
#pragma unroll
        for (int j = 0; j < 4; ++j) { v[j] = xr[64 * j]; s += (v[j].x * v[j].x + v[j].y * v[j].y) + (v[j].z * v[j].z + v[j].w * v[j].w); }
        const float rstd = 1.0f / sqrtf(wave_sum(s) * (1.f / DM) + EPS);
        f32x4* o = (f32x4*)(out + (size_t)m * DM) + X.lane;
#pragma unroll
        for (int j = 0; j < 4; ++j) { const f32x4 gv = *(const f32x4*)(g + 256 * j + 4 * X.lane); o[64 * j] = (v[j] * rstd) * gv; }
    }
}

struct Args { const float* in[23]; float* out; unsigned char* ws; };
#define AS4 __attribute__((address_space(4)))
__device__ __forceinline__ const AS4 Args* kargs() { const AS4 Args* p = (const AS4 Args*)__builtin_amdgcn_kernarg_segment_ptr(); asm volatile("" : "+s"(p)); return p; }
#define KIN(i) (kargs()->in[i])
#define WSP(T, off) ((T*)(kargs()->ws + (off)))
#ifndef REP_CV
#define REP_CV 1
#endif
#ifndef REP_S1
#define REP_S1 1
#endif
#ifndef REP_S3
#define REP_S3 1
#endif
#ifndef REP_R1
#define REP_R1 1
#endif
#ifndef REP_SORT
#define REP_SORT 1
#endif
#ifndef DOWN_GHOST
#define DOWN_GHOST 0
#endif
#ifndef REP_DOWN
#define REP_DOWN 1
#endif
#ifndef REP_COMB
#define REP_COMB 1
#endif
#ifndef REP_UP
#define REP_UP 1
#endif
#ifndef REP_N1
#define REP_N1 1
#endif
#ifndef REP_G1
#define REP_G1 1
#endif
#ifndef REP_G2
#define REP_G2 1
#endif
#ifndef REP_N2
#define REP_N2 1
#endif
#ifndef REP_G3
#define REP_G3 1
#endif
#ifndef REP_P0
#define REP_P0 1
#endif
__global__ void __launch_bounds__(NT, 2) fwd_kernel(Args args_unused) {
    extern __shared__ __attribute__((aligned(16))) unsigned char lds_raw[];
    Ctx X; X.lds = (LAS unsigned char*)lds_raw; X.tid = threadIdx.x; X.lane = X.tid & 63; X.wave = __builtin_amdgcn_readfirstlane(X.tid >> 6); X.G = gridDim.x; X.bid = blockIdx.x;
    volatile LAS unsigned* MISC = (volatile LAS unsigned*)(X.lds + MISC_OFF);
    for (int u = X.tid; u < (LDS_BYTES - LDSCTL_OFF) / 4; u += NT) ((LAS unsigned*)(X.lds + LDSCTL_OFF))[u] = 0u;
    __syncthreads();
    XcdBarrier bar = xcd_barrier_post(WSP(unsigned, WS_CTL) + CW_BAR, MISC + 8);
#define GRID_BAR() xcd_barrier(bar)

#ifndef NO_PH_MOD
    for (int _r = 0; _r < REP_P0; ++_r) p0_mod(fresh(X), KIN(1), KIN(2), KIN(3), WSP(float, WS_MOD));
#endif
#ifndef NO_PH_FOLD
    for (int _r = 0; _r < REP_P0; ++_r) p0_fold(fresh(X), KIN(6), KIN(7), WSP(float, WS_WF));
#endif
    for (int l = 0; l < 2; ++l) { p0_cvt(fresh(X), KIN(18) + (size_t)l * 131072, WSP(bf16, WS_KEYS) + (size_t)(l * 2 + 0) * 131072, 131072 / 8); p0_cvt(fresh(X), KIN(19) + (size_t)l * 131072, WSP(bf16, WS_KEYS) + (size_t)(l * 2 + 1) * 131072, 131072 / 8); }
    GRID_BAR();
#ifndef NO_PH_TR
    for (int _r = 0; _r < REP_P0; ++_r) p0_transposes(fresh(X), KIN(6), WSP(float, WS_WF), KIN(16), KIN(17), WSP(bf16, WS_WIN), WSP(bf16, WS_WOUT), WSP(bf16, WS_WQ));
#endif
    __syncthreads();

    for (int l = 0; l < 2; ++l) {
        for (int _r = 0; _r < REP_N1; ++_r) {
            const float* xin = (l == 0) ? KIN(0) : WSP(float, WS_X2); const float* modl = WSP(float, WS_MOD) + (size_t)l * 4 * 6144;
            norm_mod_phase(fresh(X), xin, KIN(4) + l * DM, modl + 0 * DM, modl + 1 * DM, WSP(bf16, WS_XN));
        }
        GRID_BAR();
        for (int _r = 0; _r < REP_G1; ++_r) {
            pg8::Gemm g{WSP(bf16, WS_XN), WSP(bf16, WS_WIN) + (size_t)l * NPROJ_PAD * 1024, M, NPROJ_PAD, DM}; const Ctx Y = fresh(X); pg8::StaticOrder S; S.init(M, NPROJ_PAD, Y.G, Y.bid);
            pg8::EpiStore E{WSP(bf16, WS_PROJ), PROJ_LD, 12, WSP(float, WS_DTRAW), 16, 16};
            pg8::gemm_phase<pg8::EpiStore, pg8::StaticOrder, true, true>(X.lds, g, S, E);
        }
        GRID_BAR();
        for (int _r = 0; _r < REP_S1; ++_r) ssd_a_phase(fresh(X), kargs()->ws, KIN(10) + (size_t)l * 4 * 1536, KIN(11) + (size_t)l * 1536, KIN(12) + l * 16, KIN(13) + l * 16);
        GRID_BAR();
#ifndef NO_PH_S2
        ssd_scan_phase(fresh(X), WSP(bf16, WS_ST), WSP(float, WS_CD));
#endif
        GRID_BAR();
        for (int _r = 0; _r < REP_S3; ++_r) ssd_c_phase(fresh(X), kargs()->ws, KIN(14) + l * 16);
        GRID_BAR();
#ifndef NO_PH_S4
        mix_finish_phase(fresh(X), WSP(bf16, WS_PROJ), WSP(float, WS_SSQ), KIN(15) + l * DM, KIN(8) + l * 512, KIN(9) + l * 512, WSP(bf16, WS_XN));
#endif
        GRID_BAR();
        for (int _r = 0; _r < REP_G2; ++_r) {
            const float* xin = (l == 0) ? KIN(0) : WSP(float, WS_X2);
            pg8::Gemm g{WSP(bf16, WS_XN), WSP(bf16, WS_WOUT) + (size_t)l * 1024 * NMIX, M, DM, NMIX}; const Ctx Y = fresh(X); pg8::StaticOrder S; S.init(M, DM, Y.G, Y.bid);
            pg8::EpiResid E{xin, kargs()->out, WSP(float, WS_MOD) + (size_t)l * 4 * 6144 + 2 * DM};
            pg8::gemm_phase<pg8::EpiResid, pg8::StaticOrder, true, true>(X.lds, g, S, E);
        }
        GRID_BAR();
        for (int _r = 0; _r < REP_N2; ++_r) {
            const float* modl = WSP(float, WS_MOD) + (size_t)l * 4 * 6144;
            norm_mod_phase(fresh(X), kargs()->out, KIN(5) + l * DM, modl + 3 * DM, modl + 4 * DM, WSP(bf16, WS_XN));
        }
        GRID_BAR();
        for (int _r = 0; _r < REP_G3; ++_r) {
            pg8::Gemm g{WSP(bf16, WS_XN), WSP(bf16, WS_WQ) + (size_t)l * NQ * 1024, M, NQ, DM}; const Ctx Y = fresh(X); pg8::StaticOrder S; S.init(M, NQ, Y.G, Y.bid);
            pg8::EpiStore E{WSP(bf16, WS_PROJ), NQ, 1 << 30, nullptr, 0, 0};
            pg8::gemm_phase<pg8::EpiStore, pg8::StaticOrder, true, true>(X.lds, g, S, E);
        }
        GRID_BAR();
#ifndef NO_PH_R1
        for (int _r = 0; _r < REP_R1; ++_r) route_phase(fresh(X), WSP(bf16, WS_PROJ), WSP(bf16, WS_KEYS) + (size_t)l * 2 * 131072, WSP(int, WS_IDX), WSP(float, WS_GATE));
#endif
        GRID_BAR();
        for (int _r = 0; _r < REP_SORT; ++_r) peer_sort_phase(fresh(X), WSP(int, WS_IDX), WSP(float, WS_GATE), WSP(int, WS_ENT), WSP(float, WS_GS), WSP(unsigned short, WS_OFF));
        GRID_BAR();
        for (int _r = 0; _r < REP_DOWN; ++_r) peer_down_phase(fresh(X), KIN(20) + (size_t)l * 16384 * 1024, WSP(bf16, WS_XN), WSP(int, WS_ENT), WSP(unsigned short, WS_OFF), WSP(unsigned, WS_LIST), WSP(float, WS_PART), _r == 0 ? 0 : DOWN_GHOST);
        GRID_BAR();
        for (int _r = 0; _r < REP_COMB; ++_r) peer_combine_phase(fresh(X), WSP(float, WS_PART), WSP(float, WS_GS), WSP(int, WS_ENT), WSP(unsigned, WS_STREAM));
        GRID_BAR();
        for (int _r = 0; _r < REP_UP; ++_r) peer_up_phase(fresh(X), KIN(21) + (size_t)l * 16384 * 1024, WSP(unsigned, WS_STREAM), kargs()->out, WSP(float, WS_MOD) + (size_t)l * 4 * 6144 + 5 * DM, WSP(float, WS_X2));
        GRID_BAR();
        if (l == 1) final_norm_phase(fresh(X), WSP(float, WS_X2), KIN(22), kargs()->out);
    }
}

extern "C" void kernel_launch(void* const* d_in, const int* in_sizes, int n_in, void* d_out, int out_size, void* d_ws, size_t ws_size, hipStream_t stream) {
    static int grid = 0;
    if (grid == 0) {
        if (n_in != 23 || out_size != M * DM || ws_size < WS_END) { fprintf(stderr, "kernel_launch: unexpected shapes (n_in %d, out %d, ws %zu); nothing launched\n", n_in, out_size, ws_size); grid = -1; return; }
        int dev = 0, cus = 0, per_cu = 0;
        if (hipGetDevice(&dev) != hipSuccess || hipDeviceGetAttribute(&cus, hipDeviceAttributeMultiprocessorCount, dev) != hipSuccess) { grid = -1; return; }
        if (hipFuncSetAttribute((const void*)fwd_kernel, hipFuncAttributeMaxDynamicSharedMemorySize, LDS_BYTES) != hipSuccess) { fprintf(stderr, "kernel_launch: hipFuncSetAttribute failed\n"); grid = -1; return; }
        if (hipOccupancyMaxActiveBlocksPerMultiprocessor(&per_cu, (const void*)fwd_kernel, NT, LDS_BYTES) != hipSuccess || per_cu < 1) { fprintf(stderr, "kernel_launch: occupancy query says %d\n", per_cu); }
        (void)hipGetLastError();
        grid = cus;
    }
    if (grid < 0) return;
    if (hipMemsetAsync((char*)d_ws + WS_CTL, 0, CTL_ZERO_BYTES, stream) != hipSuccess) { fprintf(stderr, "kernel_launch: memset failed\n"); return; }
    Args a{};
    for (int i = 0; i < 23; ++i) a.in[i] = (const float*)d_in[i];
    a.out = (float*)d_out; a.ws = (unsigned char*)d_ws;
    hipLaunchKernelGGL(fwd_kernel, dim3(grid), dim3(NT), LDS_BYTES, stream, a);
}
```

```cpp
#include <hip/hip_runtime.h>
#include <cstdio>
#include <cstdint>
namespace pg8 {
#define PG8_LAS __attribute__((address_space(3)))
typedef unsigned short bf16_t;
typedef short bf16x8 __attribute__((ext_vector_type(8)));
typedef float f32x4 __attribute__((ext_vector_type(4)));
typedef unsigned u32x4 __attribute__((ext_vector_type(4)));
constexpr int BM = 256, BK = 64, HALF = 128, HTB = HALF * BK * 2  , STAGE_BYTES = 8 * HTB, NXCD = 8, WGM = 8;

__host__ __device__ __forceinline__ int lds_byte(int r, int c) { const int st = (r >> 4) * 2 + (c >> 5), rr = r & 15, cc = c & 31, ob = rr * 64 + cc * 2; return st * 1024 + (ob ^ (((ob >> 9) & 1) << 5)); }
__host__ __device__ __forceinline__ void stage_rc(int b, int& R, int& C) { const int st = b / 1024, sb = b % 1024, swz = sb ^ (((sb >> 9) & 1) << 5); R = (st >> 1) * 16 + swz / 64; C = (st & 1) * 32 + (swz % 64) / 2; }
__host__ __device__ __forceinline__ int perm32(int rho) { const int n = rho >> 4, i = rho & 15; return 8 * (i >> 2) + 4 * n + (i & 3); }

struct Unit { int pm, pn; };
struct Gemm { const bf16_t* A; const bf16_t* Bt; int M, N, K; };

struct StaticOrder {
    int nM, nN, nwg, G, c;
    __host__ __device__ void init(int M, int N, int G_, int c_) { nM = M / BM; nN = N / BM; nwg = nM * nN; G = G_; c = c_; }
    __host__ __device__ bool next(int i, Unit& u) const {
        const long L = (long)i * G + c; if (L >= nwg) return false;
        int wgid = (int)L; { const int q = nwg / NXCD, r = nwg % NXCD, xcd = wgid % NXCD, off = wgid / NXCD; wgid = (xcd < r ? xcd * (q + 1) : r * (q + 1) + (xcd - r) * q) + off; }
        const int nig = WGM * nN, gid = wgid / nig, fm = gid * WGM, gsz = (nM - fm) < WGM ? (nM - fm) : WGM;
        u.pm = fm + ((wgid % nig) % gsz); u.pn = (wgid % nig) / gsz; return true;
    }
    __device__ __forceinline__ void a_ready(const Unit&) const {}
    __device__ __forceinline__ void done(const Unit&) const {}
};


__device__ __forceinline__ unsigned cvt_pk_bf16(float lo, float hi) { unsigned r; asm volatile("v_cvt_pk_bf16_f32 %0, %1, %2" : "=v"(r) : "v"(lo), "v"(hi)); return r; }

struct EpiStore {
    static constexpr bool PERM = true, AFTER_DRAIN = false;
    bf16_t* O; int ldc; int pn_f32; float* F32; int ld32; int ncol32;
    __device__ __forceinline__ void operator()(const f32x4 (&acc)[2][2][4][2], const Unit& u, int wr, int wc, int fr, int fq) const {
        const int row0 = u.pm * BM + wr * 64 + fr;
        if (u.pn >= pn_f32) {
#pragma unroll
            for (int ai = 0; ai < 2; ++ai)
#pragma unroll
                for (int m = 0; m < 4; ++m) { const size_t row = (size_t)(row0 + ai * HALF + m * 16);
#pragma unroll
                    for (int bj = 0; bj < 2; ++bj)
#pragma unroll
                        for (int n = 0; n < 2; ++n) { const int c0 = bj * HALF + wc * 32 + 8 * fq + 4 * n;
#pragma unroll
                            for (int j = 0; j < 4; ++j) if (c0 + j < ncol32) F32[row * ld32 + c0 + j] = acc[ai][bj][m][n][j]; } }
            return;
        }
        const int col0 = u.pn * BM + wc * 32 + 8 * fq;
#pragma unroll
        for (int ai = 0; ai < 2; ++ai)
#pragma unroll
            for (int m = 0; m < 4; ++m) { bf16_t* rowp = O + (size_t)(row0 + ai * HALF + m * 16) * ldc + col0;
#pragma unroll
                for (int bj = 0; bj < 2; ++bj) { const f32x4 v0 = acc[ai][bj][m][0], v1 = acc[ai][bj][m][1];
                    u32x4 w; w.x = cvt_pk_bf16(v0[0], v0[1]); w.y = cvt_pk_bf16(v0[2], v0[3]); w.z = cvt_pk_bf16(v1[0], v1[1]); w.w = cvt_pk_bf16(v1[2], v1[3]);
                    *(u32x4*)(rowp + bj * HALF) = w; } }
    }
};

struct EpiResid {
    static constexpr bool PERM = false, AFTER_DRAIN = false;
    const float* xin; float* out; const float* gate;
    __device__ __forceinline__ void operator()(const f32x4 (&acc)[2][2][4][2], const Unit& u, int wr, int wc, int fr, int fq) const {
        const int col0 = u.pn * BM + wc * 32 + 4 * fq;
#pragma unroll
        for (int ai = 0; ai < 2; ++ai)
#pragma unroll
            for (int m = 0; m < 4; ++m) { const int row = u.pm * BM + ai * HALF + wr * 64 + m * 16 + fr; const int b = row >> 12; const size_t off = (size_t)row * 1024 + col0;
#pragma unroll
                for (int bj = 0; bj < 2; ++bj)
#pragma unroll
                    for (int n = 0; n < 2; ++n) { const int cc = bj * HALF + n * 16;
                        const f32x4 g = *(const f32x4*)(gate + (size_t)b * 6144 + col0 + cc); const f32x4 x = *(const f32x4*)(xin + off + cc);
                        *(f32x4*)(out + off + cc) = x + g * acc[ai][bj][m][n]; } }
    }
};
template <class Epi, class Sched, bool ALIGN_EPI = false, bool SP2 = false>
__device__ __forceinline__ void gemm_phase(PG8_LAS unsigned char* lds, const Gemm g, const Sched& S, const Epi& E) {
    int tid_ = threadIdx.x; asm volatile("" : "+v"(tid_));
    const int tid = tid_, wid = __builtin_amdgcn_readfirstlane(tid >> 6), lane = tid & 63, wr = wid >> 2, wc = wid & 3, fr = lane & 15, fq = lane >> 4;
    const int K = g.K, nt = K / BK;
    unsigned voffA[2], voffB[2];
#pragma unroll
    for (int i = 0; i < 2; ++i) { int R, C; stage_rc(tid * 16 + i * 8192, R, C); const int Rb = Epi::PERM ? ((R & ~31) + perm32(R & 31)) : R;
        voffA[i] = (unsigned)(R * K + C) * 2u; voffB[i] = (unsigned)(Rb * K + C) * 2u; }
    const size_t kstep = (size_t)(BK * 2);
    const size_t hstep = (size_t)HALF * K * 2;
    const size_t tstep = 2 * hstep;
    const unsigned ldsw = (unsigned)wid * 1024u;
    const int aoff = lds_byte(wr * 64 + fr, fq * 8), boff = lds_byte(wc * 32 + fr, fq * 8);
#define PG8_SA(b, h) (((b) * 2 + (h)) * HTB)
#define PG8_SB(b, h) ((4 + (b) * 2 + (h)) * HTB)
#define PG8_STAGE(bufoff, gbase, voff) do { _Pragma("unroll") for (int _i = 0; _i < 2; ++_i) \
        __builtin_amdgcn_global_load_lds((const unsigned*)((const char*)(gbase) + (voff)[_i]), (PG8_LAS unsigned*)(lds + (bufoff) + ldsw + _i * 8192), 16, 0, 0); } while (0)
#define PG8_LDA(dst, b, h) do { _Pragma("unroll") for (int m = 0; m < 4; ++m) _Pragma("unroll") for (int k = 0; k < 2; ++k) dst[m][k] = *(const PG8_LAS bf16x8*)(lds + PG8_SA(b, h) + aoff + m * 2048 + k * 1024); } while (0)
#define PG8_LDB(dst, b, h) do { _Pragma("unroll") for (int n = 0; n < 2; ++n) _Pragma("unroll") for (int k = 0; k < 2; ++k) dst[n][k] = *(const PG8_LAS bf16x8*)(lds + PG8_SB(b, h) + boff + n * 2048 + k * 1024); } while (0)
#define PG8_MMA(ai, bj, At, Bt) do { __builtin_amdgcn_s_setprio(1); _Pragma("unroll") for (int m = 0; m < 4; ++m) _Pragma("unroll") for (int n = 0; n < 2; ++n) _Pragma("unroll") for (int k = 0; k < 2; ++k) \
        acc[ai][bj][m][n] = __builtin_amdgcn_mfma_f32_16x16x32_bf16(Bt[n][k], At[m][k], acc[ai][bj][m][n], 0, 0, 0); __builtin_amdgcn_s_setprio(0); } while (0)
#define PG8_WAIT_V(n) asm volatile("s_waitcnt vmcnt(" #n ")" ::: "memory")
#define PG8_WAIT_L(n) asm volatile("s_waitcnt lgkmcnt(" #n ")" ::: "memory")
#define PG8_BAR __builtin_amdgcn_s_barrier()
#define PG8_SCHED __builtin_amdgcn_sched_barrier(0)
    Unit cur, nxt; int ui = 0;
    if (!S.next(0, cur)) return;
    f32x4 acc[2][2][4][2];
#pragma unroll
    for (int a = 0; a < 2; ++a)
#pragma unroll
        for (int b = 0; b < 2; ++b)
#pragma unroll
            for (int m = 0; m < 4; ++m)
#pragma unroll
                for (int n = 0; n < 2; ++n) acc[a][b][m][n] = (f32x4){0.f, 0.f, 0.f, 0.f};
    bf16x8 At[4][2], B0[2][2], B1[2][2];
    const char* cA = (const char*)g.A + (size_t)cur.pm * tstep; const char* cB = (const char*)g.Bt + (size_t)cur.pn * tstep;
    S.a_ready(cur);
    if constexpr (SP2) {
        PG8_STAGE(PG8_SB(0, 0), cB, voffB); PG8_STAGE(PG8_SB(0, 1), cB + hstep, voffB); PG8_STAGE(PG8_SA(0, 0), cA, voffA); PG8_STAGE(PG8_SA(0, 1), cA + hstep, voffA);
        if (wr == 1) PG8_BAR;
        PG8_WAIT_V(2); PG8_BAR;
        PG8_STAGE(PG8_SB(1, 0), cB + kstep, voffB); PG8_STAGE(PG8_SA(1, 0), cA + kstep, voffA); PG8_STAGE(PG8_SB(1, 1), cB + hstep + kstep, voffB);
        PG8_WAIT_V(6); PG8_BAR;
    } else {
        PG8_STAGE(PG8_SB(0, 0), cB, voffB); PG8_STAGE(PG8_SA(0, 0), cA, voffA); PG8_STAGE(PG8_SB(0, 1), cB + hstep, voffB); PG8_STAGE(PG8_SA(0, 1), cA + hstep, voffA);
        if (wr == 1) PG8_BAR;
        PG8_WAIT_V(4); PG8_BAR;
        PG8_STAGE(PG8_SB(1, 0), cB + kstep, voffB); PG8_STAGE(PG8_SA(1, 0), cA + kstep, voffA); PG8_STAGE(PG8_SB(1, 1), cB + hstep + kstep, voffB);
        PG8_WAIT_V(6); PG8_BAR;
    }
    for (;;) {
        const bool has_next = S.next(ui + 1, nxt);
        const char* nA = has_next ? (const char*)g.A + (size_t)nxt.pm * tstep : cA; const char* nB = has_next ? (const char*)g.Bt + (size_t)nxt.pn * tstep : cB;
        for (int t = 0; t < nt; t += 2) {
            const bool last = (t == nt - 2);
            const char* a1 = cA + (size_t)(t + 1) * kstep;
            const char* a2 = last ? nA : cA + (size_t)(t + 2) * kstep; const char* b2 = last ? nB : cB + (size_t)(t + 2) * kstep;
            const char* a3 = a2 + kstep; const char* b3 = b2 + kstep;
            if (last && has_next) S.a_ready(nxt);
            if constexpr (SP2) {
            PG8_LDB(B0, 0, 0); PG8_LDB(B1, 0, 1); PG8_SCHED; PG8_LDA(At, 0, 0); PG8_STAGE(PG8_SA(1, 1), a1 + hstep, voffA);
            PG8_WAIT_V(8); PG8_WAIT_L(0); PG8_BAR; PG8_MMA(0, 0, At, B0); PG8_MMA(0, 1, At, B1); PG8_BAR; PG8_SCHED;
            PG8_LDA(At, 0, 1); PG8_STAGE(PG8_SB(0, 0), b2, voffB); PG8_STAGE(PG8_SB(0, 1), b2 + hstep, voffB); PG8_STAGE(PG8_SA(0, 0), a2, voffA);
            PG8_WAIT_V(8); PG8_WAIT_L(0); PG8_BAR; PG8_MMA(1, 0, At, B0); PG8_MMA(1, 1, At, B1); PG8_BAR; PG8_SCHED;
            PG8_LDB(B0, 1, 0); PG8_LDB(B1, 1, 1); PG8_SCHED; PG8_LDA(At, 1, 0); PG8_STAGE(PG8_SA(0, 1), a2 + hstep, voffA);
            PG8_WAIT_V(8); PG8_WAIT_L(0); PG8_BAR; PG8_MMA(0, 0, At, B0); PG8_MMA(0, 1, At, B1); PG8_BAR; PG8_SCHED;
            PG8_LDA(At, 1, 1); PG8_STAGE(PG8_SB(1, 0), b3, voffB); PG8_STAGE(PG8_SB(1, 1), b3 + hstep, voffB); PG8_STAGE(PG8_SA(1, 0), a3, voffA);
            PG8_WAIT_V(8); PG8_WAIT_L(0); PG8_BAR; PG8_MMA(1, 0, At, B0); PG8_MMA(1, 1, At, B1); PG8_BAR; PG8_SCHED;
            } else {
            PG8_LDB(B0, 0, 0); PG8_SCHED; PG8_LDA(At, 0, 0); PG8_STAGE(PG8_SA(1, 1), a1 + hstep, voffA);
            PG8_WAIT_L(8); PG8_BAR; PG8_WAIT_L(0); PG8_MMA(0, 0, At, B0); PG8_BAR; PG8_SCHED;
            PG8_LDB(B1, 0, 1); PG8_STAGE(PG8_SB(0, 0), b2, voffB);
            PG8_BAR; PG8_WAIT_L(0); PG8_MMA(0, 1, At, B1); PG8_BAR;
            PG8_LDA(At, 0, 1); PG8_STAGE(PG8_SA(0, 0), a2, voffA);
            PG8_BAR; PG8_WAIT_L(0); PG8_MMA(1, 0, At, B0); PG8_BAR; PG8_SCHED;
            PG8_STAGE(PG8_SB(0, 1), b2 + hstep, voffB);
            PG8_WAIT_V(6); PG8_BAR; PG8_MMA(1, 1, At, B1); PG8_BAR;
            PG8_LDB(B0, 1, 0); PG8_SCHED; PG8_LDA(At, 1, 0); PG8_STAGE(PG8_SA(0, 1), a2 + hstep, voffA);
            PG8_WAIT_L(8); PG8_BAR; PG8_WAIT_L(0); PG8_MMA(0, 0, At, B0); PG8_BAR; PG8_SCHED;
            PG8_LDB(B1, 1, 1); PG8_STAGE(PG8_SB(1, 0), b3, voffB);
            PG8_BAR; PG8_WAIT_L(0); PG8_MMA(0, 1, At, B1); PG8_BAR;
            PG8_LDA(At, 1, 1); PG8_STAGE(PG8_SA(1, 0), a3, voffA);
            PG8_BAR; PG8_WAIT_L(0); PG8_MMA(1, 0, At, B0); PG8_BAR; PG8_SCHED;
            PG8_STAGE(PG8_SB(1, 1), b3 + hstep, voffB);
            PG8_WAIT_V(6); PG8_BAR; PG8_MMA(1, 1, At, B1); PG8_BAR;
            }
        }
        if constexpr (ALIGN_EPI) { if (wr == 0) PG8_BAR; }
        if constexpr (!Epi::AFTER_DRAIN) { E(acc, cur, wr, wc, fr, fq); S.done(cur); }
        if (!has_next) break;
#pragma unroll
        for (int a = 0; a < 2; ++a)
#pragma unroll
            for (int b = 0; b < 2; ++b)
#pragma unroll
                for (int m = 0; m < 4; ++m)
#pragma unroll
                    for (int n = 0; n < 2; ++n) acc[a][b][m][n] = (f32x4){0.f, 0.f, 0.f, 0.f};
        cur = nxt; cA = nA; cB = nB; ++ui;
        if constexpr (ALIGN_EPI) { if (wr == 1) PG8_BAR; }
    }
    PG8_WAIT_V(0);
    if constexpr (!ALIGN_EPI) { if (wr == 0) PG8_BAR; }
    PG8_BAR;
    if constexpr (Epi::AFTER_DRAIN) { E.fused(acc, cur, wr, wc, fr, fq, lds, wid, lane); S.done(cur); }
#undef PG8_SA
#undef PG8_SB
#undef PG8_STAGE
#undef PG8_LDA
#undef PG8_LDB
#undef PG8_MMA
#undef PG8_WAIT_V
#undef PG8_WAIT_L
#undef PG8_BAR
#undef PG8_SCHED
}
}
#define GAS __attribute__((address_space(1)))
#define LAS __attribute__((address_space(3)))
typedef unsigned short bf16;
typedef unsigned v4u __attribute__((ext_vector_type(4)));
typedef float f32x4 __attribute__((ext_vector_type(4)));
typedef short bf16x8 __attribute__((ext_vector_type(8)));
typedef GAS unsigned gu32;
typedef GAS unsigned long long gu64;
#define RLX_AGENT __ATOMIC_RELAXED, __HIP_MEMORY_SCOPE_AGENT
#define LDS_WAIT() asm volatile("s_waitcnt lgkmcnt(0)" ::: "memory")
#define VM_WAIT() asm volatile("s_waitcnt vmcnt(0)" ::: "memory")
__device__ __forceinline__ unsigned long long rt() { return __builtin_amdgcn_s_memrealtime(); }
__device__ __forceinline__ unsigned f2bf(float f) { unsigned u = __builtin_bit_cast(unsigned, f); return (u + 0x7fffu + ((u >> 16) & 1u)) >> 16; }
__device__ __forceinline__ unsigned pk2(float lo, float hi) { return f2bf(lo) | (f2bf(hi) << 16); }

#define XB_TMO      128
#define XB_XCNT(j)  (256  + 64 * (j))
#define XB_XSUB(j)  (1280 + 64 * (j))
#define XB_XGEN(j)  (2304 + 64 * (j))
#define XB_TOP      3328
#define XB_TOPGEN   3392
#define XCD_BAR_WORDS 3456
#define XB_SPIN_CAP (1u << 18)

__device__ __forceinline__ unsigned xb_ld(unsigned* p)              { return __hip_atomic_load(p, __ATOMIC_RELAXED, __HIP_MEMORY_SCOPE_AGENT); }
__device__ __forceinline__ unsigned xb_add(unsigned* p, unsigned v) { return __hip_atomic_fetch_add(p, v, __ATOMIC_RELAXED, __HIP_MEMORY_SCOPE_AGENT); }
__device__ __forceinline__ unsigned xb_xcc_id() { return (unsigned)__builtin_amdgcn_s_getreg((3 << 11) | 20) & 0xFu; }
#define XB_SPIN(cond, bar) do { unsigned _sp = 0; while (cond) { __builtin_amdgcn_s_sleep(1); \
    if ((++_sp & 255u) == 0u) { if (xb_ld(&(bar)[XB_TMO])) break; if (_sp > XB_SPIN_CAP) { atomicAdd(&(bar)[XB_TMO], 1u); break; } } } } while (0)

struct XcdBarrier {
    unsigned* bar; unsigned x;
    volatile LAS unsigned* st;
};

__device__ __forceinline__ XcdBarrier xcd_barrier_post(unsigned* bar, volatile LAS unsigned* st) {
    XcdBarrier b; b.bar = bar; b.x = xb_xcc_id(); b.st = st;
    if (threadIdx.x == 0) (void)xb_add(&bar[XB_XCNT(b.x)], 1u);
    return b;
}
__device__ __forceinline__ void xcd_barrier_complete(unsigned* bar, unsigned x, unsigned& nloc, unsigned& nx) {
    const unsigned G = gridDim.x * gridDim.y * gridDim.z;
    unsigned sum, cnt, mine, sp = 0u;
    for (;;) {
        sum = 0u; cnt = 0u; mine = 0u;
#pragma unroll
        for (unsigned j = 0; j < 16; ++j) { const unsigned c = xb_ld(&bar[XB_XCNT(j)]); sum += c; cnt += (c > 0u) ? 1u : 0u; mine = (j == x) ? c : mine; }
        if (sum == G) break;
        __builtin_amdgcn_s_sleep(1);
        if ((++sp & 255u) == 0u) { if (xb_ld(&bar[XB_TMO])) break; if (sp > XB_SPIN_CAP) { atomicAdd(&bar[XB_TMO], 1u); break; } }
    }
    nloc = mine > 0u ? mine : 1u; nx = cnt > 0u ? cnt : 1u;
}

__device__ __forceinline__ void xcd_barrier(const XcdBarrier& b) {
    asm volatile("s_waitcnt vmcnt(0)" ::: "memory");
    __syncthreads();
    if (threadIdx.x == 0) {
        unsigned* bar = b.bar;
        __builtin_amdgcn_s_waitcnt(0);
        unsigned nloc = b.st[0], nx = b.st[1];
        if (nloc == 0u) { xcd_barrier_complete(bar, b.x, nloc, nx); b.st[0] = nloc; b.st[1] = nx; }
        const unsigned old = xb_add(&bar[XB_XSUB(b.x)], 1u);
        const unsigned gen = old / nloc;
        if (old + 1u == (gen + 1u) * nloc) {
            __builtin_amdgcn_fence(__ATOMIC_RELEASE, "agent");
            asm volatile("s_waitcnt vmcnt(0)" ::: "memory");
            const unsigned og = xb_add(&bar[XB_TOP], 1u);
            const unsigned tg = og / nx;
            if (og + 1u == (tg + 1u) * nx) xb_add(&bar[XB_TOPGEN], 1u);
            else XB_SPIN(xb_ld(&bar[XB_TOPGEN]) == tg, bar);
            __builtin_amdgcn_fence(__ATOMIC_ACQUIRE, "agent");
            xb_add(&bar[XB_XGEN(b.x)], 1u);
            asm volatile("s_waitcnt vmcnt(0)" ::: "memory");
        } else {
            XB_SPIN(xb_ld(&bar[XB_XGEN(b.x)]) == gen, bar);
            __builtin_amdgcn_fence(__ATOMIC_ACQUIRE, "agent");
            asm volatile("s_waitcnt vmcnt(0)" ::: "memory");
        }
    }
    __syncthreads();
}

constexpr int NWAVES = 8, NT = 512;
constexpr int BATCH = 4, SEQ = 4096, DM = 1024, M = BATCH * SEQ;
constexpr int NPROJ = 3088, NPROJ_PAD = 3328, PROJ_LD = 3072, NMIX = 1536, NQ = 2048;
constexpr int NBC = M / 128;
constexpr float EPS = 1e-6f;
typedef float f32x16 __attribute__((ext_vector_type(16)));
typedef unsigned v2u __attribute__((ext_vector_type(2)));

constexpr size_t MiB = 1u << 20;
constexpr size_t WS_CTL = 0, CTL_ZERO_BYTES = 64 * 1024;
constexpr size_t WS_MOD = 1 * MiB, WS_KEYS = 2 * MiB, WS_CD = 3 * MiB;
constexpr size_t WS_WIN = 4 * MiB, WS_WOUT = 17 * MiB, WS_WQ = 23 * MiB;
constexpr size_t WS_PART = 32 * MiB, WS_ENT = 96 * MiB, WS_GS = 104 * MiB, WS_OFF = 112 * MiB, WS_STREAM = 113 * MiB, WS_LIST = 121 * MiB;
constexpr size_t WS_XN = 160 * MiB;
constexpr size_t WS_PROJ = 208 * MiB;
constexpr size_t WS_ST = 304 * MiB;
constexpr size_t WS_X2 = 336 * MiB;
constexpr size_t WS_CBC = 400 * MiB;
constexpr size_t WS_XBT = 416 * MiB;
constexpr size_t WS_WF = 456 * MiB;
constexpr size_t WS_DTRAW = 460 * MiB, WS_DTV = 461 * MiB, WS_ACS = 462 * MiB, WS_SSQ = 463 * MiB;
constexpr size_t WS_IDX = 464 * MiB, WS_GATE = 472 * MiB;
constexpr size_t WS_END = 480 * MiB;
constexpr int CW_BAR = 1024;
static_assert((CW_BAR + XCD_BAR_WORDS) * 4 <= (int)CTL_ZERO_BYTES, "ctl");

constexpr int RING_BYTES = 131072, LDS_BYTES = 163840, LDSCTL_OFF = LDS_BYTES - 512, MISC_OFF = LDSCTL_OFF + 320;

__device__ __forceinline__ float bflo(unsigned w) { return __uint_as_float(w << 16); }
__device__ __forceinline__ float bfhi(unsigned w) { return __uint_as_float(w & 0xffff0000u); }
__device__ __forceinline__ float bf2f(unsigned short h) { return __uint_as_float(((unsigned)h) << 16); }
__device__ __forceinline__ float siluf(float x) { return x / (1.f + __expf(-x)); }
__device__ __forceinline__ float wave_sum(float v) {
#pragma unroll
    for (int o = 1; o < 64; o <<= 1) v += __shfl_xor(v, o);
    return v;
}
__device__ __forceinline__ int rowoff(int reg, int h) { return (reg & 3) + 8 * (reg >> 2) + 4 * h; }
#define MFMA32(a, b, c) __builtin_amdgcn_mfma_f32_32x32x16_bf16((a), (b), (c), 0, 0, 0)
#define LDS_BARRIER() do { asm volatile("s_waitcnt lgkmcnt(0)" ::: "memory"); __builtin_amdgcn_s_barrier(); asm volatile("" ::: "memory"); } while (0)
#define DPP_ADD(v, ctrl) ((v) + __int_as_float(__builtin_amdgcn_update_dpp(0, __float_as_int(v), (ctrl), 0xF, 0xF, true)))

struct Ctx { LAS unsigned char* lds; int tid, lane, wave, G, bid; };
__device__ __forceinline__ Ctx fresh(const Ctx& X) { Ctx Y; Y.lds = X.lds; int t = X.tid; asm volatile("" : "+v"(t)); int g = X.G, b = X.bid; asm volatile("" : "+s"(g), "+s"(b)); Y.tid = t; Y.lane = t & 63; Y.wave = __builtin_amdgcn_readfirstlane(t >> 6); Y.G = g; Y.bid = b; return Y; }

__device__ __forceinline__ void p0_mod(const Ctx& X, const float* c, const float* w_ada, const float* b_ada, float* MOD) {
    LAS float* cs = (LAS float*)X.lds; LAS float* red = (LAS float*)(X.lds + 16384);
    for (int i = X.tid; i < 4096; i += NT) cs[i] = siluf(c[i]);
    __syncthreads();
    for (int item = X.bid; item < 192; item += X.G) {
        const int l = item / 96, cc = item % 96, col = cc * 64 + X.lane;
        const float* W = w_ada + (size_t)l * 1024 * 6144 + col;
        float a0 = 0.f, a1 = 0.f, a2 = 0.f, a3 = 0.f;
#pragma unroll 8
        for (int kk = 0; kk < 128; ++kk) { const int k = X.wave * 128 + kk; const float w = W[(size_t)k * 6144];
            a0 += cs[k] * w; a1 += cs[1024 + k] * w; a2 += cs[2048 + k] * w; a3 += cs[3072 + k] * w; }
        red[(X.wave * 4 + 0) * 64 + X.lane] = a0; red[(X.wave * 4 + 1) * 64 + X.lane] = a1; red[(X.wave * 4 + 2) * 64 + X.lane] = a2; red[(X.wave * 4 + 3) * 64 + X.lane] = a3;
        __syncthreads();
        if (X.tid < 256) { const int b = X.tid >> 6, ln = X.tid & 63; float s = 0.f;
#pragma unroll
            for (int w = 0; w < 8; ++w) s += red[(w * 4 + b) * 64 + ln];
            MOD[((size_t)l * 4 + b) * 6144 + cc * 64 + ln] = s + b_ada[(size_t)l * 6144 + cc * 64 + ln]; }
        __syncthreads();
    }
}
__device__ __forceinline__ void p0_fold(const Ctx& X, const float* w_in, const float* pool_w, float* WF) {
    const int gt = X.bid * NT + X.tid, GT = X.G * NT;
    for (int o = gt; o < 2 * 1024 * 512; o += GT) {
        const int n = o & 511, k = (o >> 9) & 1023, l = o >> 19, g = n >> 7, d = n & 127;
        const float* wi = w_in + ((size_t)l * 1024 + k) * NPROJ + g * 128;
        const float* pw = pool_w + ((size_t)(l * 4 + g) * 128) * 128 + d;
        float s = 0.f;
#pragma unroll 8
        for (int c = 0; c < 128; ++c) s += wi[c] * pw[(size_t)c * 128];
        WF[o] = s;
    }
}
__device__ __forceinline__ void p0_cvt(const Ctx& X, const float* src, bf16* dst, size_t n8) {
    const size_t gt = (size_t)X.bid * NT + X.tid, GT = (size_t)X.G * NT;
    for (size_t i = gt; i < n8; i += GT) {
        const f32x4 a = ((const f32x4*)src)[2 * i], b = ((const f32x4*)src)[2 * i + 1];
        v4u o; o.x = pk2(a.x, a.y); o.y = pk2(a.z, a.w); o.z = pk2(b.x, b.y); o.w = pk2(b.z, b.w);
        ((v4u*)dst)[i] = o;
    }
}
__device__ __forceinline__ void tr_item(const float* W, int ldw, int nvalid, int K, bf16* WT, LAS float* scr, int kb, int n_src0, int n_dst0, int lane) {
    const int k0 = 64 * kb;
#pragma unroll 8
    for (int i = 0; i < 32; ++i) { const int kk = 2 * i + (lane >> 5); const int n = n_src0 + (lane & 31);
        scr[kk * 33 + (lane & 31)] = (n < nvalid) ? W[(size_t)(k0 + kk) * ldw + n] : 0.f; }
    LDS_WAIT(); asm volatile("" ::: "memory");
    const int c = lane & 7;
#pragma unroll
    for (int j = 0; j < 4; ++j) { const int n = (lane >> 3) + 8 * j; const LAS float* s = scr + (8 * c) * 33 + n;
        v4u o; o.x = pk2(s[0 * 33], s[1 * 33]); o.y = pk2(s[2 * 33], s[3 * 33]); o.z = pk2(s[4 * 33], s[5 * 33]); o.w = pk2(s[6 * 33], s[7 * 33]);
        *(v4u*)(WT + (size_t)(n_dst0 + n) * K + k0 + 8 * c) = o; }
    LDS_WAIT(); asm volatile("" ::: "memory");
}
__device__ __forceinline__ void p0_transposes(const Ctx& X, const float* w_in, const float* WF, const float* w_out, const float* w_query, bf16* WIN, bf16* WOUT, bf16* WQ) {
    LAS float* scr = (LAS float*)(X.lds + X.wave * 16384);
    const int gw = X.bid * NWAVES + X.wave, NGW = X.G * NWAVES;
    constexpr int I_IN = 16 * 104, I_OUT = 24 * 32, I_Q = 16 * 64, I_L = I_IN + I_OUT + I_Q;
    for (int it = gw; it < 2 * I_L; it += NGW) {
        const int l = it / I_L; int r = it % I_L;
        if (r < I_IN) { const int kb = r / 104, nb = r % 104;
            if (nb < 16) tr_item(WF + (size_t)l * 1024 * 512, 512, 512, 1024, WIN + (size_t)l * NPROJ_PAD * 1024, scr, kb, nb * 32, nb * 32, X.lane);
            else tr_item(w_in + (size_t)l * 1024 * NPROJ, NPROJ, NPROJ, 1024, WIN + (size_t)l * NPROJ_PAD * 1024, scr, kb, nb * 32, nb * 32, X.lane);
            continue; }
        r -= I_IN;
        if (r < I_OUT) { const int kb = r / 32, nb = r % 32; tr_item(w_out + (size_t)l * NMIX * 1024, 1024, 1024, NMIX, WOUT + (size_t)l * 1024 * NMIX, scr, kb, nb * 32, nb * 32, X.lane); continue; }
        r -= I_OUT;
        { const int kb = r / 64, nb = r % 64; tr_item(w_query + (size_t)l * 1024 * NQ, NQ, NQ, 1024, WQ + (size_t)l * NQ * 1024, scr, kb, nb * 32, nb * 32, X.lane); }
    }
}
__device__ __forceinline__ void norm_mod_phase(const Ctx& X, const float* xin, const float* g, const float* shift, const float* scale, bf16* XN) {
    const int gw = X.bid * NWAVES + X.wave, NGW = X.G * NWAVES;
    for (int m0 = gw * 2; m0 < M; m0 += NGW * 2) {
        f32x4 v[2][4]; float s[2] = {0.f, 0.f};
#pragma unroll
        for (int e = 0; e < 2; ++e) { const f32x4* xr = (const f32x4*)(xin + (size_t)(m0 + e) * DM) + X.lane;
#pragma unroll
            for (int j = 0; j < 4; ++j) v[e][j] = xr[64 * j]; }
        const int b = m0 >> 12;
        f32x4 gv[4], sc[4], sh[4];
#pragma unroll
        for (int j = 0; j < 4; ++j) { const int col = 256 * j + 4 * X.lane; gv[j] = *(const f32x4*)(g + col); sc[j] = *(const f32x4*)(scale + (size_t)b * 6144 + col); sh[j] = *(const f32x4*)(shift + (size_t)b * 6144 + col); }
#pragma unroll
        for (int e = 0; e < 2; ++e)
#pragma unroll
            for (int j = 0; j < 4; ++j) s[e] += (v[e][j].x * v[e][j].x + v[e][j].y * v[e][j].y) + (v[e][j].z * v[e][j].z + v[e][j].w * v[e][j].w);
#pragma unroll
        for (int e = 0; e < 2; ++e) {
            const float rstd = 1.0f / sqrtf(wave_sum(s[e]) * (1.f / DM) + EPS);
            unsigned long long* o8 = (unsigned long long*)(XN + (size_t)(m0 + e) * DM) + X.lane;
#pragma unroll
            for (int j = 0; j < 4; ++j) { const f32x4 o = (v[e][j] * rstd) * gv[j] * (sc[j] + 1.0f) + sh[j];
                o8[64 * j] = (unsigned long long)pk2(o.x, o.y) | ((unsigned long long)pk2(o.z, o.w) << 32); }
        }
    }
}
typedef float f32x4m __attribute__((ext_vector_type(4)));
__device__ __forceinline__ void dt_proj_phase(const Ctx& X, const bf16* XN, const bf16* WT, float* DTRAW) {
    const int gw = X.bid * NWAVES + X.wave, NGW = X.G * NWAVES, rr = X.lane & 15, kg = X.lane >> 4;
    for (int tile = gw; tile < M / 16; tile += NGW) {
        const bf16* arow = XN + (size_t)(tile * 16 + rr) * DM + 8 * kg; const bf16* brow = WT + (size_t)(3072 + rr) * DM + 8 * kg;
        f32x4m acc = {0.f, 0.f, 0.f, 0.f};
#pragma unroll 8
        for (int ks = 0; ks < 32; ++ks) acc = __builtin_amdgcn_mfma_f32_16x16x32_bf16(*(const bf16x8*)(arow + 32 * ks), *(const bf16x8*)(brow + 32 * ks), acc, 0, 0, 0);
#pragma unroll
        for (int i = 0; i < 4; ++i) DTRAW[(size_t)(tile * 16 + 4 * kg + i) * 16 + rr] = acc[i];
    }
}
__device__ __forceinline__ void ssd_a_phase(const Ctx& X, unsigned char* ws, const float* conv_w, const float* conv_b, const float* dt_bias, const float* a_log) {
#define PROJ ((const bf16*)(ws + WS_PROJ))
#define DTRAW ((const float*)(ws + WS_DTRAW))
#define CBC ((bf16*)(ws + WS_CBC))
#define XBT ((bf16*)(ws + WS_XBT))
#define DTV ((float*)(ws + WS_DTV))
#define ACS ((float*)(ws + WS_ACS))
#define CD ((float*)(ws + WS_CD))
#define ST ((bf16*)(ws + WS_ST))
    LAS unsigned char* raw = X.lds;
    LAS unsigned char* BT = X.lds + 67648;
    LAS unsigned char* XTL = X.lds + 102464;
    LAS float* dts = (LAS float*)(X.lds + 119872); LAS float* acsL = dts + 1024; LAS float* wl = dts + 2048;
    LAS float* CW = (LAS float*)(X.lds + 132224);
    const int r_ = X.lane & 31, h = X.lane >> 5;
    for (int u = X.bid; u < NBC * 2; u += X.G) {
        const int bc = u >> 1, g = u & 1, c = bc & 31, t0 = bc * 128;
        {
            v4u rv[9];
#pragma unroll
            for (int k = 0; k < 9; ++k) { const int i = X.tid + k * NT; const int r = (i >> 5) < 131 ? (i >> 5) : 130, ck = i & 31; const int pos = c * 128 + r - 3;
                const int tr = pos >= 0 ? t0 + r - 3 : t0; const int col = (ck < 16 ? 2560 + g * 128 : 2816 + g * 128 - 128) + ck * 8;
                rv[k] = *(const v4u*)(PROJ + (size_t)tr * PROJ_LD + col); if (pos < 0) rv[k] = (v4u){0u, 0u, 0u, 0u}; }
#pragma unroll
            for (int k = 0; k < 9; ++k) { const int i = X.tid + k * NT; const int r = i >> 5, ck = i & 31;
                if (r < 131) { LAS unsigned* d = (LAS unsigned*)(raw + r * 516 + ck * 16); d[0] = rv[k].x; d[1] = rv[k].y; d[2] = rv[k].z; d[3] = rv[k].w; } }
        }
        for (int i = X.tid; i < 3840; i += NT) { const int j = i / 768, cl = i % 768; const int chx = cl < 512 ? g * 512 + cl : (cl < 640 ? 1024 + g * 128 + cl - 512 : 1280 + g * 128 + cl - 640);
            CW[i] = j < 4 ? conv_w[j * 1536 + chx] : conv_b[chx]; }
#pragma unroll
        for (int k = 0; k < 2; ++k) { const int i = X.tid + k * NT, r = i >> 7, l = i & 127, hh = g * 8 + r;
            const float x = DTRAW[(size_t)(t0 + l) * 16 + hh] + dt_bias[hh]; const float ex = __expf(x);
            const float dt = x > 20.f ? x : (ex < 0.015625f ? ex * (1.f - ex * (0.5f - ex * 0.33333333f)) : __logf(1.f + ex));
            dts[i] = dt; wl[i] = -dt * __expf(a_log[hh]); }
        __syncthreads();
        {
            const int cp = X.tid & 127, lr = X.tid >> 7, ch = 2 * cp, cl = 512 + ch;
            float w0[4], w1[4];
#pragma unroll
            for (int j = 0; j < 4; ++j) { w0[j] = CW[j * 768 + cl]; w1[j] = CW[j * 768 + cl + 1]; }
            const float b0 = CW[4 * 768 + cl], b1 = CW[4 * 768 + cl + 1];
            bf16* dst = CBC + (size_t)t0 * 512 + (ch < 128 ? g * 128 + ch : 256 + g * 128 + ch - 128);
            for (int l = 32 * lr; l < 32 * lr + 32; ++l) { float a0 = b0, a1 = b1;
#pragma unroll
                for (int j = 0; j < 4; ++j) { const unsigned w = *(LAS unsigned*)(raw + (l + j) * 516 + cp * 4); a0 += w0[j] * bflo(w); a1 += w1[j] * bfhi(w); }
                *(unsigned*)(dst + (size_t)l * 512) = pk2(siluf(a0), siluf(a1)); }
        }
        {
            const int l = X.tid & 127, cr = X.tid >> 7;
            for (int ci = 0; ci < 32; ++ci) { const int ch = cr * 32 + ci, cl = 512 + ch;
                float a = CW[4 * 768 + cl];
#pragma unroll
                for (int j = 0; j < 4; ++j) a += CW[j * 768 + cl] * bf2f(*(LAS unsigned short*)(raw + (l + j) * 516 + ch * 2));
                *(LAS unsigned short*)(BT + ch * 272 + l * 2) = (unsigned short)f2bf(siluf(a)); }
        }
        {
#pragma unroll
            for (int k = 0; k < 2; ++k) { const int i = X.tid + k * NT; float v = wl[i];
#pragma unroll
                for (int o = 1; o < 64; o <<= 1) { const float up = __shfl_up(v, o); if (X.lane >= o) v += up; }
                acsL[i] = v; }
        }
        __syncthreads();
#pragma unroll
        for (int k = 0; k < 2; ++k) { const int i = X.tid + k * NT; if (i & 64) acsL[i] += acsL[(i & ~127) + 63]; }
        __syncthreads();
#pragma unroll
        for (int k = 0; k < 2; ++k) { const int i = X.tid + k * NT, r = i >> 7, l = i & 127, hh = g * 8 + r; const float tot = acsL[(i & ~127) + 127], a = acsL[i];
            wl[i] = __expf(tot - a) * dts[i];
            DTV[(size_t)(bc * 16 + hh) * 128 + l] = dts[i]; ACS[(size_t)(bc * 16 + hh) * 128 + l] = a; if (l == 0) CD[bc * 16 + hh] = __expf(tot); }
        v4u xv[3];
#define SA_XLOAD(hh_) { _Pragma("unroll") for (int k = 0; k < 3; ++k) { const int i = X.tid + k * NT; const int r = (i >> 3) < 131 ? (i >> 3) : 130, ck = i & 7; const int pos = c * 128 + r - 3; \
            const int tr = pos >= 0 ? t0 + r - 3 : t0; xv[k] = *(const v4u*)(PROJ + (size_t)tr * PROJ_LD + 1536 + (hh_) * 64 + ck * 8); if (pos < 0) xv[k] = (v4u){0u, 0u, 0u, 0u}; } }
        SA_XLOAD(g * 8)
        __syncthreads();
#pragma unroll 1
        for (int r = 0; r < 8; ++r) {
            const int hh = g * 8 + r;
#pragma unroll
            for (int k = 0; k < 3; ++k) { const int i = X.tid + k * NT; const int rr = i >> 3, ck = i & 7;
                if (rr < 131) { LAS unsigned* d = (LAS unsigned*)(raw + rr * 132 + ck * 16); d[0] = xv[k].x; d[1] = xv[k].y; d[2] = xv[k].z; d[3] = xv[k].w; } }
            LDS_BARRIER();
            if (r < 7) SA_XLOAD(hh + 1)
            {
                const int l = X.tid & 127, cq = X.tid >> 7;
                for (int ci = 0; ci < 16; ++ci) { const int p = cq * 16 + ci, chx = hh * 64 + p, cl = r * 64 + p;
                    float a = CW[4 * 768 + cl];
#pragma unroll
                    for (int j = 0; j < 4; ++j) a += CW[j * 768 + cl] * bf2f(*(LAS unsigned short*)(raw + (l + j) * 132 + p * 2));
                    const unsigned short o = (unsigned short)f2bf(siluf(a));
                    *(LAS unsigned short*)(XTL + p * 272 + l * 2) = o; XBT[((size_t)bc * 1024 + chx) * 128 + l] = o; }
            }
            LDS_BARRIER();
            {
                const int pb = X.wave & 1, nb = X.wave >> 1;
                const LAS unsigned char* xrow = XTL + (32 * pb + r_) * 272; const LAS unsigned char* brow = BT + (32 * nb + r_) * 272; const LAS float* wr = wl + r * 128;
                f32x16 acc;
#pragma unroll
                for (int i = 0; i < 16; ++i) acc[i] = 0.f;
#pragma unroll
                for (int ks = 0; ks < 8; ++ks) { const int k0 = 16 * ks + 8 * h;
                    const v4u xa = *(const LAS v4u*)(xrow + k0 * 2); const bf16x8 bb = *(const LAS bf16x8*)(brow + k0 * 2);
                    v4u sa; sa.x = pk2(bflo(xa.x) * wr[k0 + 0], bfhi(xa.x) * wr[k0 + 1]); sa.y = pk2(bflo(xa.y) * wr[k0 + 2], bfhi(xa.y) * wr[k0 + 3]);
                    sa.z = pk2(bflo(xa.z) * wr[k0 + 4], bfhi(xa.z) * wr[k0 + 5]); sa.w = pk2(bflo(xa.w) * wr[k0 + 6], bfhi(xa.w) * wr[k0 + 7]);
                    acc = MFMA32(__builtin_bit_cast(bf16x8, sa), bb, acc); }
                bf16* so = ST + ((size_t)(bc * 16 + hh) * 64) * 128;
#pragma unroll
                for (int i = 0; i < 16; ++i) { const int p = 32 * pb + rowoff(i, h); so[(size_t)p * 128 + 32 * nb + r_] = (bf16)f2bf(acc[i]); }
            }
            LDS_BARRIER();
        }
#undef SA_XLOAD
    }
#undef PROJ
#undef DTRAW
#undef CBC
#undef XBT
#undef DTV
#undef ACS
#undef CD
#undef ST
}
__device__ __forceinline__ void ssd_scan_phase(const Ctx& X, bf16* ST, const float* CD) {
    const int gt = X.bid * NT + X.tid, GT = X.G * NT;
    for (int e = gt; e < 131072; e += GT) {
        const int n4 = e & 31, p = (e >> 5) & 63, hh = (e >> 11) & 15, b = e >> 15;
        bf16* base = ST + ((size_t)((b * 32) * 16 + hh) * 64 + p) * 128 + n4 * 4;
        v2u st[32];
#pragma unroll
        for (int c = 0; c < 32; ++c) st[c] = *(const v2u*)(base + (size_t)c * 131072);
        float h0 = 0.f, h1 = 0.f, h2 = 0.f, h3 = 0.f;
#pragma unroll
        for (int c = 0; c < 32; ++c) { const float cd = CD[(b * 32 + c) * 16 + hh];
            v2u o; o.x = pk2(h0, h1); o.y = pk2(h2, h3); *(v2u*)(base + (size_t)c * 131072) = o;
            h0 = h0 * cd + bflo(st[c].x); h1 = h1 * cd + bfhi(st[c].x); h2 = h2 * cd + bflo(st[c].y); h3 = h3 * cd + bfhi(st[c].y); }
    }
}
__device__ __forceinline__ void ssd_c_phase(const Ctx& X, unsigned char* ws, const float* d_skip) {
#define PROJ ((const bf16*)(ws + WS_PROJ))
#define CBC ((const bf16*)(ws + WS_CBC))
#define XBT ((const bf16*)(ws + WS_XBT))
#define DTV ((const float*)(ws + WS_DTV))
#define ACS ((const float*)(ws + WS_ACS))
#define ST ((const bf16*)(ws + WS_ST))
#define YA ((bf16*)(ws + WS_XN))
#define SSQ ((float*)(ws + WS_SSQ))
    LAS unsigned char* CT = X.lds;
    LAS unsigned char* BK = X.lds + 34816;
    LAS unsigned char* XTL = BK; LAS unsigned char* HPL = BK + 17408;
    LAS unsigned char* ML = X.lds + 69632;
    LAS float* acsL = (LAS float*)(X.lds + 104448); LAS float* dtL = acsL + 1024; LAS float* eaL = acsL + 2048; LAS float* ssqL = acsL + 3072;
    const int r_ = X.lane & 31, h = X.lane >> 5;
    for (int u = X.bid; u < NBC * 2; u += X.G) {
        const int bc = u >> 1, g = u & 1, t0 = bc * 128;
        {
            v4u cv[4], bv[4];
#pragma unroll
            for (int k = 0; k < 4; ++k) { const int i = X.tid + k * NT, row = i >> 4, ck = i & 15;
                cv[k] = *(const v4u*)(CBC + (size_t)(t0 + row) * 512 + 256 + g * 128 + ck * 8); bv[k] = *(const v4u*)(CBC + (size_t)(t0 + row) * 512 + g * 128 + ck * 8); }
            float av[2], dv[2];
#pragma unroll
            for (int k = 0; k < 2; ++k) { const int i = X.tid + k * NT; av[k] = ACS[(size_t)(bc * 16 + g * 8) * 128 + i]; dv[k] = DTV[(size_t)(bc * 16 + g * 8) * 128 + i]; }
#pragma unroll
            for (int k = 0; k < 4; ++k) { const int i = X.tid + k * NT, row = i >> 4, ck = i & 15; *(LAS v4u*)(CT + row * 272 + ck * 16) = cv[k]; *(LAS v4u*)(BK + row * 272 + ck * 16) = bv[k]; }
#pragma unroll
            for (int k = 0; k < 2; ++k) { const int i = X.tid + k * NT; acsL[i] = av[k]; dtL[i] = dv[k]; eaL[i] = __expf(av[k]); }
        }
        v4u xr[2], hr[2];
#define SC_XHLOAD(hh_) { _Pragma("unroll") for (int k = 0; k < 2; ++k) { const int i = X.tid + k * NT; \
            xr[k] = *(const v4u*)(XBT + ((size_t)bc * 1024 + (hh_) * 64) * 128 + (size_t)i * 8); hr[k] = *(const v4u*)(ST + ((size_t)(bc * 16 + (hh_)) * 64) * 128 + (size_t)i * 8); } }
        SC_XHLOAD(g * 8)
        __syncthreads();
        f32x16 cb[2];
        const int lb = X.wave >> 1, sh = X.wave & 1;
#pragma unroll
        for (int j = 0; j < 2; ++j) { const int sb = 2 * sh + j;
#pragma unroll
            for (int i = 0; i < 16; ++i) cb[j][i] = 0.f;
            if (sb <= lb) {
                const LAS unsigned char* crow = CT + (32 * lb + r_) * 272; const LAS unsigned char* brow = BK + (32 * sb + r_) * 272;
#pragma unroll
                for (int ks = 0; ks < 8; ++ks) { const int k0 = 16 * ks + 8 * h; cb[j] = MFMA32(*(const LAS bf16x8*)(crow + k0 * 2), *(const LAS bf16x8*)(brow + k0 * 2), cb[j]); }
            }
        }
        __syncthreads();
#pragma unroll 1
        for (int r = 0; r < 8; ++r) {
            const int hh = g * 8 + r; const LAS float* ac = acsL + r * 128; const LAS float* dl = dtL + r * 128; const LAS float* ea = eaL + r * 128;
#pragma unroll
            for (int k = 0; k < 2; ++k) { const int i = X.tid + k * NT, row = i >> 4, ck = i & 15; *(LAS v4u*)(XTL + row * 272 + ck * 16) = xr[k]; *(LAS v4u*)(HPL + row * 272 + ck * 16) = hr[k]; }
#pragma unroll
            for (int j = 0; j < 2; ++j) { const int sb = 2 * sh + j;
                if (sb <= lb) { const int s_ = 32 * sb + r_; const float as = ac[s_], ds = dl[s_];
#pragma unroll
                    for (int i = 0; i < 16; ++i) { const int l = 32 * lb + rowoff(i, h); const float vv = cb[j][i] * __expf(ac[l] - as) * ds; const unsigned msk = (unsigned)((l - s_) >> 31);
                        *(LAS unsigned short*)(ML + l * 272 + s_ * 2) = (unsigned short)f2bf(__uint_as_float(__float_as_uint(vv) & ~msk));
                        if ((i & 3) == 3) __builtin_amdgcn_sched_barrier(0); } }
            }
            LDS_BARRIER();
            if (r < 7) SC_XHLOAD(hh + 1)
            {
                const int lb2 = X.wave >> 1, pb = X.wave & 1, p = 32 * pb + r_;
                unsigned short zv[16];
                const char* zb = (const char*)PROJ + ((size_t)(t0 + 32 * lb2) * PROJ_LD + 512 + hh * 64) * 2; const unsigned zo = (unsigned)(4 * h * PROJ_LD + p) * 2u;
#pragma unroll
                for (int i = 0; i < 16; ++i) zv[i] = *(const unsigned short*)(zb + (size_t)((i & 3) + 8 * (i >> 2)) * PROJ_LD * 2 + zo);
                f32x16 accd, acco;
#pragma unroll
                for (int i = 0; i < 16; ++i) { accd[i] = 0.f; acco[i] = 0.f; }
                const LAS unsigned char* mrow = ML + (32 * lb2 + r_) * 272; const LAS unsigned char* xrow = XTL + p * 272;
                for (int ks = 0; ks < 2 * (lb2 + 1); ++ks) { const int k0 = 16 * ks + 8 * h; accd = MFMA32(*(const LAS bf16x8*)(mrow + k0 * 2), *(const LAS bf16x8*)(xrow + k0 * 2), accd); }
                const LAS unsigned char* crow = CT + (32 * lb2 + r_) * 272; const LAS unsigned char* hrow = HPL + p * 272;
#pragma unroll 4
                for (int ks = 0; ks < 8; ++ks) { const int k0 = 16 * ks + 8 * h; acco = MFMA32(*(const LAS bf16x8*)(crow + k0 * 2), *(const LAS bf16x8*)(hrow + k0 * 2), acco); }
                const float dsk = d_skip[hh];
                char* yb = (char*)YA + ((size_t)(t0 + 32 * lb2) * NMIX + 512 + hh * 64) * 2; const unsigned yo = (unsigned)(4 * h * NMIX + p) * 2u;
#pragma unroll
                for (int i = 0; i < 16; ++i) { const int l = 32 * lb2 + rowoff(i, h);
                    float y = accd[i] + ea[l] * acco[i];
                    y += dsk * bf2f(*(const LAS unsigned short*)(xrow + l * 2));
                    const float yg = y * siluf(bf2f(zv[i]));
                    *(unsigned short*)(yb + (size_t)((i & 3) + 8 * (i >> 2)) * NMIX * 2 + yo) = (unsigned short)f2bf(yg);
                    float q = yg * yg;
                    q = DPP_ADD(q, 0xB1); q = DPP_ADD(q, 0x4E); q = DPP_ADD(q, 0x141); q = DPP_ADD(q, 0x140); q += __shfl_xor(q, 16);
                    if (r_ == 0) ssqL[l * 2 + pb] = q;
                    if ((i & 3) == 3) __builtin_amdgcn_sched_barrier(0); }
            }
            LDS_BARRIER();
            if (X.tid < 128) SSQ[(size_t)(t0 + X.tid) * 16 + hh] = ssqL[X.tid * 2] + ssqL[X.tid * 2 + 1];
            LDS_BARRIER();
        }
#undef SC_XHLOAD
    }
#undef PROJ
#undef CBC
#undef XBT
#undef DTV
#undef ACS
#undef ST
#undef YA
#undef SSQ
}
__device__ __forceinline__ void mix_finish_phase(const Ctx& X, const bf16* PROJ, const float* SSQ, const float* ssd_norm, const float* pool_b, const float* pool_scale, bf16* YA) {
    for (int rb = X.bid; rb < M / 64; rb += X.G) {
        const int t0 = rb * 64 + X.wave * 8, pos0 = t0 & 4095;
        {
            v4u ya[8][2]; float q[8];
#pragma unroll
            for (int i = 0; i < 8; ++i) { const bf16* yp = YA + (size_t)(t0 + i) * NMIX + 512 + 8 * X.lane; ya[i][0] = *(const v4u*)yp; ya[i][1] = *(const v4u*)(yp + 512);
                q[i] = (X.lane < 16) ? SSQ[(size_t)(t0 + i) * 16 + X.lane] : 0.f; }
            f32x4 gn[2][2];
#pragma unroll
            for (int hf = 0; hf < 2; ++hf) { gn[hf][0] = *(const f32x4*)(ssd_norm + hf * 512 + 8 * X.lane); gn[hf][1] = *(const f32x4*)(ssd_norm + hf * 512 + 8 * X.lane + 4); }
#pragma unroll
            for (int i = 0; i < 8; ++i) { const float rstd = 1.0f / sqrtf(wave_sum(q[i]) * (1.f / 1024.f) + EPS);
#pragma unroll
                for (int hf = 0; hf < 2; ++hf) { const v4u v = ya[i][hf]; const f32x4 g0 = gn[hf][0], g1 = gn[hf][1];
                    v4u o; o.x = pk2(bflo(v.x) * rstd * g0.x, bfhi(v.x) * rstd * g0.y); o.y = pk2(bflo(v.y) * rstd * g0.z, bfhi(v.y) * rstd * g0.w);
                    o.z = pk2(bflo(v.z) * rstd * g1.x, bfhi(v.z) * rstd * g1.y); o.w = pk2(bflo(v.w) * rstd * g1.z, bfhi(v.w) * rstd * g1.w);
                    *(v4u*)(YA + (size_t)(t0 + i) * NMIX + 512 + hf * 512 + 8 * X.lane) = o; } }
        }
#pragma unroll 1
        for (int hb = 0; hb < 2; ++hb) {
            const int tb = t0 + 4 * hb, pb0 = pos0 + 4 * hb;
            const int ch = 8 * X.lane, w = 2 << (X.lane >> 4);
            v4u u[19];
#pragma unroll
            for (int k = 0; k < 19; ++k) { const bool ok = pb0 - 15 + k >= 0; const int tr = ok ? tb - 15 + k : tb; u[k] = *(const v4u*)(PROJ + (size_t)tr * PROJ_LD + ch); if (!ok) u[k] = (v4u){0u, 0u, 0u, 0u}; }
            float mk[16];
#pragma unroll
            for (int j = 0; j < 16; ++j) mk[j] = (j < w) ? 1.f : 0.f;
            float S[4][8];
#pragma unroll
            for (int i = 0; i < 4; ++i)
#pragma unroll
                for (int e = 0; e < 8; ++e) S[i][e] = 0.f;
#pragma unroll
            for (int k = 0; k < 19; ++k) { const float f[8] = {bflo(u[k].x), bfhi(u[k].x), bflo(u[k].y), bfhi(u[k].y), bflo(u[k].z), bfhi(u[k].z), bflo(u[k].w), bfhi(u[k].w)};
#pragma unroll
                for (int i = 0; i < 4; ++i) { const int j = 15 + i - k; if (j >= 0 && j < 16) {
#pragma unroll
                    for (int e = 0; e < 8; ++e) S[i][e] += mk[j] * f[e]; } } }
            const f32x4 b0 = *(const f32x4*)(pool_b + ch), b1 = *(const f32x4*)(pool_b + ch + 4), c0 = *(const f32x4*)(pool_scale + ch), c1 = *(const f32x4*)(pool_scale + ch + 4);
            const float bb[8] = {b0.x, b0.y, b0.z, b0.w, b1.x, b1.y, b1.z, b1.w}, cc[8] = {c0.x, c0.y, c0.z, c0.w, c1.x, c1.y, c1.z, c1.w};
#pragma unroll
            for (int i = 0; i < 4; ++i) { const int pos = pb0 + i; const float inv = 1.0f / (float)((pos + 1 < w) ? (pos + 1) : w); const v4u cu = u[15 + i];
                const float cur[8] = {bflo(cu.x), bfhi(cu.x), bflo(cu.y), bfhi(cu.y), bflo(cu.z), bfhi(cu.z), bflo(cu.w), bfhi(cu.w)};
                float o[8];
#pragma unroll
                for (int e = 0; e < 8; ++e) o[e] = (S[i][e] * inv - cur[e] + bb[e]) * cc[e];
                v4u ov; ov.x = pk2(o[0], o[1]); ov.y = pk2(o[2], o[3]); ov.z = pk2(o[4], o[5]); ov.w = pk2(o[6], o[7]);
                *(v4u*)(YA + (size_t)(tb + i) * NMIX + ch) = ov; }
        }
    }
}
__device__ __forceinline__ unsigned f2key(float f) { const unsigned b = __float_as_uint(f); return b ^ ((unsigned)((int)b >> 31) | 0x80000000u); }
__device__ __forceinline__ float key2f(unsigned u) { const unsigned b = (u & 0x80000000u) ? (u ^ 0x80000000u) : ~u; return __uint_as_float(b); }
__device__ __forceinline__ void cs_desc(unsigned& a, unsigned& b) { const unsigned hi = a > b ? a : b, lo = a > b ? b : a; a = hi; b = lo; }
__device__ __forceinline__ void bitonic_sort16_desc(unsigned (&a)[16]) {
#pragma unroll
    for (int k = 2; k <= 16; k <<= 1)
#pragma unroll
        for (int j = k >> 1; j > 0; j >>= 1)
#pragma unroll
            for (int i = 0; i < 16; ++i) { const int l = i ^ j; if (l > i) { if ((i & k) == 0) cs_desc(a[i], a[l]); else cs_desc(a[l], a[i]); } }
}
__device__ __forceinline__ void merge_top16_desc(unsigned (&a)[16], const unsigned (&b)[16]) {
#pragma unroll
    for (int i = 0; i < 16; ++i) a[i] = a[i] > b[15 - i] ? a[i] : b[15 - i];
#pragma unroll
    for (int j = 8; j > 0; j >>= 1)
#pragma unroll
        for (int i = 0; i < 16; ++i) { const int l = i ^ j; if (l > i) cs_desc(a[i], a[l]); }
}
#define INSK(L, kk) do { unsigned _v = (kk); _Pragma("unroll") for (int _j = 0; _j < 16; ++_j) { const unsigned _t = L[_j] > _v ? L[_j] : _v; _v = L[_j] > _v ? _v : L[_j]; L[_j] = _t; } } while (0)
__device__ __forceinline__ void route_phase(const Ctx& X, const bf16* Q, const bf16* KEYS_l, int* IDX, float* GATE) {
    LAS bf16* KL = (LAS bf16*)X.lds;
    const int r = X.lane & 31, h = X.lane >> 5;
    for (int u = X.bid; u < (M / 256) * 8; u += X.G) {
        const int tb = u >> 3, hd = u & 7;
        for (int i = X.tid; i < 4096; i += NT) { const int half = i >> 11, row = (i >> 4) & 127, ck = i & 15;
            const v4u v = *(const v4u*)(KEYS_l + ((size_t)(half * 8 + hd) * 128 + row) * 128 + ck * 8);
            *(LAS v4u*)(KL + (half * 128 + row) * 136 + ck * 8) = v; }
        __syncthreads();
        const int tok = tb * 256 + X.wave * 32 + r;
        unsigned K1[16], L[16];
#pragma unroll
        for (int half = 0; half < 2; ++half) {
            f32x16 acc[4];
#pragma unroll
            for (int mt = 0; mt < 4; ++mt)
#pragma unroll
                for (int i = 0; i < 16; ++i) acc[mt][i] = 0.f;
            const bf16* qrow = Q + (size_t)tok * NQ + hd * 256 + half * 128;
#pragma unroll
            for (int ks = 0; ks < 8; ++ks) { const int k0 = 16 * ks + 8 * h; const bf16x8 qb = *(const bf16x8*)(qrow + k0);
#pragma unroll
                for (int mt = 0; mt < 4; ++mt) acc[mt] = MFMA32(*(const LAS bf16x8*)(KL + (half * 128 + 32 * mt + r) * 136 + k0), qb, acc[mt]); }
            {
                unsigned G1[16], G2[16], G3[16];
#pragma unroll
                for (int i = 0; i < 16; ++i) { L[i] = (f2key(acc[0][i]) & ~127u) | (unsigned)(0 + rowoff(i, h)); G1[i] = (f2key(acc[1][i]) & ~127u) | (unsigned)(32 + rowoff(i, h));
                    G2[i] = (f2key(acc[2][i]) & ~127u) | (unsigned)(64 + rowoff(i, h)); G3[i] = (f2key(acc[3][i]) & ~127u) | (unsigned)(96 + rowoff(i, h)); }
                bitonic_sort16_desc(L); bitonic_sort16_desc(G1); bitonic_sort16_desc(G2); bitonic_sort16_desc(G3);
                merge_top16_desc(L, G1); merge_top16_desc(G2, G3); merge_top16_desc(L, G2);
                unsigned S[16];
#pragma unroll
                for (int j = 0; j < 16; ++j) S[j] = (unsigned)__shfl_xor((int)L[j], 32);
                merge_top16_desc(L, S);
            }
            if (half == 0) {
#pragma unroll
                for (int j = 0; j < 16; ++j) K1[j] = L[j];
            }
        }
        float V1[16], V2[16];
#pragma unroll
        for (int j = 0; j < 16; ++j) { V1[j] = key2f(K1[j] & ~127u); V2[j] = key2f(L[j] & ~127u); }
        unsigned C[16];
#pragma unroll
        for (int j = 0; j < 16; ++j) C[j] = 0u;
#pragma unroll
        for (int a = 0; a < 16; ++a)
#pragma unroll
            for (int b = 0; b < 16; ++b) if ((a + 1) * (b + 1) <= 16) INSK(C, (f2key(V1[a] + V2[b]) & ~255u) | (unsigned)(a * 16 + b));
        float e[16], s = 0.f; const float top = key2f(C[0] & ~255u);
#pragma unroll
        for (int j = 0; j < 16; ++j) { e[j] = __expf(key2f(C[j] & ~255u) - top); s += e[j]; }
        const float inv = 1.0f / s;
        int* ip = IDX + (size_t)tok * 128 + hd * 16; float* gp = GATE + (size_t)tok * 128 + hd * 16;
        LAS unsigned char* sc8 = (LAS unsigned char*)(X.lds + 73728) + X.tid * 32;
        { v4u p1, p2;
          p1.x = (K1[0] & 127u) | ((K1[1] & 127u) << 8) | ((K1[2] & 127u) << 16) | ((K1[3] & 127u) << 24); p1.y = (K1[4] & 127u) | ((K1[5] & 127u) << 8) | ((K1[6] & 127u) << 16) | ((K1[7] & 127u) << 24);
          p1.z = (K1[8] & 127u) | ((K1[9] & 127u) << 8) | ((K1[10] & 127u) << 16) | ((K1[11] & 127u) << 24); p1.w = (K1[12] & 127u) | ((K1[13] & 127u) << 8) | ((K1[14] & 127u) << 16) | ((K1[15] & 127u) << 24);
          p2.x = (L[0] & 127u) | ((L[1] & 127u) << 8) | ((L[2] & 127u) << 16) | ((L[3] & 127u) << 24); p2.y = (L[4] & 127u) | ((L[5] & 127u) << 8) | ((L[6] & 127u) << 16) | ((L[7] & 127u) << 24);
          p2.z = (L[8] & 127u) | ((L[9] & 127u) << 8) | ((L[10] & 127u) << 16) | ((L[11] & 127u) << 24); p2.w = (L[12] & 127u) | ((L[13] & 127u) << 8) | ((L[14] & 127u) << 16) | ((L[15] & 127u) << 24);
          *(LAS v4u*)sc8 = p1; *(LAS v4u*)(sc8 + 16) = p2; }
#pragma unroll
        for (int j = 0; j < 16; ++j) {
            const unsigned a = (C[j] >> 4) & 15u, b = C[j] & 15u;
            const unsigned i1 = sc8[a], i2 = sc8[16 + b];
            if (h == (j >> 3)) { ip[j] = (int)(i1 * 128u + i2); gp[j] = e[j] * inv; }
        }
        __syncthreads();
    }
}
__device__ __forceinline__ void peer_sort_phase(const Ctx& X, const int* IDX, const float* GATE, int* ENT, float* GS, unsigned short* OFFT) {
    LAS unsigned char* OL = X.lds;
    for (int tile = X.bid; tile < M / 64; tile += X.G) {
        int pe0[8], pe1[8]; float pg0[8], pg1[8];
#pragma unroll
        for (int i = 0; i < 8; ++i) { const size_t t = (size_t)tile * 64 + X.wave * 8 + i;
            pe0[i] = IDX[t * 128 + X.lane]; pe1[i] = IDX[t * 128 + 64 + X.lane]; pg0[i] = GATE[t * 128 + X.lane]; pg1[i] = GATE[t * 128 + 64 + X.lane]; }
#pragma unroll
        for (int i = 0; i < 8; ++i) {
            const int tl = X.wave * 8 + i, t = tile * 64 + tl;
            const int e0 = pe0[i], e1 = pe1[i]; const float g0 = pg0[i], g1 = pg1[i];
            const unsigned key0 = ((unsigned)(e0 >> 9) << 7) | (unsigned)X.lane, key1 = ((unsigned)(e1 >> 9) << 7) | (unsigned)(64 + X.lane);
            int pos0 = 0, pos1 = 0, cnt = 0;
#pragma unroll 8
            for (int j = 0; j < 64; ++j) {
                const unsigned a = (unsigned)__builtin_amdgcn_readlane((int)key0, j), b = (unsigned)__builtin_amdgcn_readlane((int)key1, j);
                pos0 += (a < key0) + (b < key0); pos1 += (a < key1) + (b < key1);
                cnt += ((a >> 7) < (unsigned)X.lane) + ((b >> 7) < (unsigned)X.lane);
            }
            ENT[(size_t)t * 128 + pos0] = e0; ENT[(size_t)t * 128 + pos1] = e1; GS[(size_t)t * 128 + pos0] = g0; GS[(size_t)t * 128 + pos1] = g1;
            if (X.lane <= 32) OL[tl * 40 + X.lane] = (unsigned char)cnt;
        }
        __syncthreads();
        for (int i = X.tid; i < 2048; i += NT) { const int c = i >> 6, tl = i & 63; const unsigned o0 = OL[tl * 40 + c], o1 = OL[tl * 40 + c + 1];
            OFFT[(size_t)c * M + tile * 64 + tl] = (unsigned short)(o0 | ((o1 - o0) << 8)); }
        __syncthreads();
    }
}
typedef __bf16 bf16x2_t __attribute__((ext_vector_type(2)));
typedef short s16x4_t __attribute__((ext_vector_type(4)));
__device__ __forceinline__ float dot2bf(unsigned a, unsigned b, float c) { return __builtin_amdgcn_fdot2_f32_bf16(__builtin_bit_cast(bf16x2_t, a), __builtin_bit_cast(bf16x2_t, b), c, false); }
__device__ __forceinline__ void down_load_ent(const int* ENT, const bf16* XN, unsigned w, int q, int rot, int s, int base, int (&ent)[4], v4u (&hv)[4]) {
    const int t = (int)(w >> 16), off0 = (int)(w & 0xffu);
    { int p = off0 + base + 4 * q; p = p < 124 ? p : 124; const v4u ev = *(const v4u*)(ENT + (size_t)t * 128 + p); const int sh = off0 + base + 4 * q - p;
      ent[0] = (int)(sh == 0 ? ev.x : (sh == 1 ? ev.y : (sh == 2 ? ev.z : ev.w))); ent[1] = (int)(sh == 0 ? ev.y : (sh == 1 ? ev.z : ev.w)); ent[2] = (int)(sh == 0 ? ev.z : ev.w); ent[3] = (int)ev.w; }
#pragma unroll
    for (int ii = 0; ii < 4; ++ii) hv[ii] = *(const v4u*)(XN + (size_t)t * DM + s * 128 + (4 * ((ii + rot) & 3) + q) * 8);
}
__device__ __forceinline__ void down_compute(LAS unsigned char* DL, float* PART, unsigned w, int s, int q, int rot, int nb, int base, const int (&ent)[4], const v4u (&hv)[4]) {
    const int t = (int)(w >> 16), off0 = (int)(w & 0xffu), n = (int)((w >> 8) & 0xffu);
    float res[4] = {0.f, 0.f, 0.f, 0.f};
    v4u dA[4], dB[4], dC[4], dD[4];
#define DOWN_ROW(i, D) { const int e_ = __builtin_amdgcn_update_dpp(0, ent[(i) & 3], (((i) >> 2) & 3) * 0x55, 0xF, 0xF, true); const LAS unsigned char* rp_ = DL + (e_ & 511) * 256 + q * 16; \
        D[0] = *(const LAS v4u*)(rp_ + ((0 + rot) & 3) * 64); D[1] = *(const LAS v4u*)(rp_ + ((1 + rot) & 3) * 64); D[2] = *(const LAS v4u*)(rp_ + ((2 + rot) & 3) * 64); D[3] = *(const LAS v4u*)(rp_ + ((3 + rot) & 3) * 64); }
#define DOWN_MATH(i, D) { f32x4 ca = {0.f, 0.f, 0.f, 0.f}, cb = {0.f, 0.f, 0.f, 0.f}; \
        _Pragma("unroll") for (int ii = 0; ii < 4; ++ii) { \
            ca = __builtin_amdgcn_mfma_f32_4x4x4bf16_1k(__builtin_bit_cast(s16x4_t, (v2u){D[ii].x, D[ii].y}), __builtin_bit_cast(s16x4_t, (v2u){hv[ii].x, hv[ii].y}), ca, 0, 0, 0); \
            cb = __builtin_amdgcn_mfma_f32_4x4x4bf16_1k(__builtin_bit_cast(s16x4_t, (v2u){D[ii].z, D[ii].w}), __builtin_bit_cast(s16x4_t, (v2u){hv[ii].z, hv[ii].w}), cb, 0, 0, 0); } \
        const f32x4 c4 = ca + cb; float acc = q == 0 ? c4[0] : (q == 1 ? c4[1] : (q == 2 ? c4[2] : c4[3]));     \
        acc = DPP_ADD(acc, 0xB1); acc = DPP_ADD(acc, 0x4E); \
        if (q == (((i) >> 2) & 3)) res[(i) & 3] = acc; }
#define DOWN_STEP2(i, Dc0, Dc1, Dn0, Dn1) { if ((i) >= nb) goto down_done; DOWN_ROW((i) + 2, Dn0) DOWN_ROW((i) + 3, Dn1) __builtin_amdgcn_sched_barrier(0); DOWN_MATH(i, Dc0) DOWN_MATH((i) + 1, Dc1) __builtin_amdgcn_sched_barrier(0); }
    DOWN_ROW(0, dA) DOWN_ROW(1, dB)
    DOWN_STEP2(0, dA, dB, dC, dD) DOWN_STEP2(2, dC, dD, dA, dB) DOWN_STEP2(4, dA, dB, dC, dD) DOWN_STEP2(6, dC, dD, dA, dB)
    DOWN_STEP2(8, dA, dB, dC, dD) DOWN_STEP2(10, dC, dD, dA, dB) DOWN_STEP2(12, dA, dB, dC, dD) DOWN_STEP2(14, dC, dD, dA, dB)
    down_done:;
#undef DOWN_STEP2
#undef DOWN_ROW
#undef DOWN_MATH
#pragma unroll
    for (int r = 0; r < 4; ++r) { const int j = base + 4 * q + r; if (j < n) PART[((size_t)s * M + t) * 128 + off0 + j] = res[r]; }
}
__device__ __forceinline__ int wave_max_i(int v) {
#pragma unroll
    for (int o = 4; o < 64; o <<= 1) { const int u = __shfl_xor(v, o); v = u > v ? u : v; }
    return __builtin_amdgcn_readfirstlane(v);
}
constexpr int LIST_STRIDE = 16384 + 64;
__device__ __forceinline__ void peer_down_phase(const Ctx& X, const float* e_down_l, const bf16* XN, const int* ENT, const unsigned short* OFFT, unsigned* LISTG, float* PART, int ghost) {
    LAS unsigned char* DL = X.lds;
    LAS unsigned* HB = (LAS unsigned*)(X.lds + 132096);
    const int q = X.lane & 3, tg = X.lane >> 2, rot = (tg >> 1) & 3;
    for (int role = X.bid; role < 256; role += X.G) {
        const int s = role & 7, c = role >> 3;
        for (int i = X.tid; i < 1040; i += NT) HB[i] = 0u;
#pragma unroll 1
        for (int i0 = X.tid; i0 < 512 * 32; i0 += NT * 8) {
            f32x4 v[8]; const char* db = (const char*)(e_down_l + (size_t)(c * 512) * DM + s * 128); const unsigned vo = (unsigned)((i0 >> 5) * DM + (i0 & 31) * 4) * 4u;
#pragma unroll
            for (int u = 0; u < 8; ++u) v[u] = *(const f32x4*)(db + (size_t)u * 16 * DM * 4 + vo);
#pragma unroll
            for (int u = 0; u < 8; ++u) { const int i = i0 + u * NT; v2u o; o.x = pk2(v[u].x, v[u].y); o.y = pk2(v[u].z, v[u].w); *(LAS v2u*)(DL + (i >> 5) * 256 + (i & 31) * 8) = o; }
        }
        __syncthreads();
        const unsigned short* oc = OFFT + (size_t)c * M; unsigned* LIST = LISTG + (size_t)role * LIST_STRIDE;
        unsigned wv[32];
#pragma unroll
        for (int u = 0; u < 32; ++u) wv[u] = oc[X.tid + u * NT];
#pragma unroll
        for (int u = 0; u < 32; ++u) { const unsigned n = wv[u] >> 8; if (n) __hip_atomic_fetch_add(HB + (u >> 2) * 64 + (n < 63u ? n : 63u), 1u, __ATOMIC_RELAXED, __HIP_MEMORY_SCOPE_WORKGROUP); }
        __syncthreads();
        if (X.tid == 0) { unsigned acc = 0u; for (int wdw = 0; wdw < 8; ++wdw) for (int n = 63; n >= 1; --n) { HB[512 + wdw * 64 + n] = acc; acc += HB[wdw * 64 + n]; } HB[1024] = acc; }
        __syncthreads();
        const int total = (int)HB[1024];
#pragma unroll
        for (int u = 0; u < 32; ++u) { const unsigned n = wv[u] >> 8; if (n) { const unsigned pos = __hip_atomic_fetch_add(HB + 512 + (u >> 2) * 64 + (n < 63u ? n : 63u), 1u, __ATOMIC_RELAXED, __HIP_MEMORY_SCOPE_WORKGROUP);
            LIST[pos] = ((unsigned)(X.tid + u * NT) << 16) | wv[u]; } }
        if (X.tid < 32) LIST[total + X.tid] = 0u;
        asm volatile("s_waitcnt vmcnt(0)" ::: "memory");
        __syncthreads();
        const int nbatch = ghost == 3 ? 0 : (total + 15) >> 4, lim = total + 15;
#define LWORD(bi_) ({ int ix_ = 16 * (bi_) + tg; ix_ = ix_ < lim ? ix_ : lim; LIST[ix_]; })
        unsigned wA, wB, wC; int entA[4], entB[4]; v4u hvA[4], hvB[4];
        int bi = X.wave;
        wA = LWORD(bi); wB = LWORD(bi + NWAVES); wC = LWORD(bi + 2 * NWAVES);
        down_load_ent(ENT, XN, wA, q, rot, s, 0, entA, hvA);
        down_load_ent(ENT, XN, wB, q, rot, s, 0, entB, hvB);
#pragma unroll 1
        for (; bi < nbatch; bi += NWAVES) {
            unsigned wD; int entC[4]; v4u hvC[4];
            wD = LWORD(bi + 3 * NWAVES);
            down_load_ent(ENT, XN, wC, q, rot, s, 0, entC, hvC);
            if (ghost == 1) { if (wA == 0xffffffffu) PART[wA >> 16] = __uint_as_float(hvA[0].x + hvA[1].y + hvA[2].z + hvA[3].w + entA[0] + entA[1] + entA[2] + entA[3]); }
            else {
                const int nb = wave_max_i((int)((wA >> 8) & 0xffu));
                down_compute(DL, PART, wA, s, q, rot, nb, 0, entA, hvA);
                for (int base = 16; base < nb; base += 16) {
                    int entX[4]; v4u hvX[4]; down_load_ent(ENT, XN, wA, q, rot, s, base, entX, hvX);
                    down_compute(DL, PART, wA, s, q, rot, nb - base, base, entX, hvA);
                }
            }
            wA = wB; wB = wC; wC = wD;
#pragma unroll
            for (int r = 0; r < 4; ++r) { entA[r] = entB[r]; hvA[r] = hvB[r]; entB[r] = entC[r]; hvB[r] = hvC[r]; }
        }
#undef LWORD
        __syncthreads();
    }
}
__device__ __forceinline__ float gelu_erf(float x) { return 0.5f * x * (1.0f + erff(x * 0.70710678118654752f)); }
__device__ __forceinline__ void peer_combine_phase(const Ctx& X, const float* PART, const float* GS, const int* ENT, unsigned* STREAM, const float* e_up_l) {
    LAS unsigned* T = (LAS unsigned*)(X.lds + 131072);
    LAS unsigned char* UL = X.lds;
    const bool prefill = (X.G == 256); const int cg = (X.bid & 7) * 32 + (X.bid >> 3);
    int fb = 0;
    for (int tile = X.bid; tile < M / 64; tile += X.G) {
#pragma unroll 1
        for (int hf = 0; hf < 2; ++hf) {
#pragma unroll 1
            for (int i0 = X.tid; i0 < 4096; i0 += NT * 4) {
                f32x4 fv[8]; const int e0 = X.tid + fb * NT * 8; const bool dofill = prefill && fb < 4;
                if (dofill) { const unsigned vo = (unsigned)(e0 * DM + cg * 4) * 4u;
#pragma unroll
                    for (int u = 0; u < 8; ++u) fv[u] = *(const f32x4*)((const char*)e_up_l + (size_t)u * NT * DM * 4 + vo); }
                float pa[4][8], gs[4]; int en[4];
#pragma unroll
                for (int k = 0; k < 4; ++k) { const size_t idx = (size_t)(tile * 64 + hf * 32) * 128 + i0 + k * NT;
#pragma unroll
                    for (int s = 0; s < 8; ++s) pa[k][s] = PART[(size_t)s * M * 128 + idx];
                    gs[k] = GS[idx]; en[k] = ENT[idx]; }
#pragma unroll
                for (int k = 0; k < 4; ++k) { const int i = i0 + k * NT, tl = i >> 7, pos = i & 127;
                    const float a = ((pa[k][0] + pa[k][1]) + (pa[k][2] + pa[k][3])) + ((pa[k][4] + pa[k][5]) + (pa[k][6] + pa[k][7]));
                    T[pos * 33 + tl] = ((unsigned)en[k] << 16) | f2bf(gs[k] * gelu_erf(a)); }
                if (dofill) {
#pragma unroll
                    for (int u = 0; u < 8; ++u) { v2u o; o.x = pk2(fv[u].x, fv[u].y); o.y = pk2(fv[u].z, fv[u].w); *(LAS v2u*)(UL + (e0 + u * NT) * 8) = o; }
                }
                ++fb;
            }
            __syncthreads();
            for (int i = X.tid; i < 1024; i += NT) { const int p4 = i >> 5, tl = i & 31; v4u o; o.x = T[(4 * p4 + 0) * 33 + tl]; o.y = T[(4 * p4 + 1) * 33 + tl]; o.z = T[(4 * p4 + 2) * 33 + tl]; o.w = T[(4 * p4 + 3) * 33 + tl];
                ((v4u*)STREAM)[(size_t)(tile * 32 + p4) * 64 + hf * 32 + tl] = o; }
            __syncthreads();
        }
    }
}
typedef _Float16 h2_t __attribute__((ext_vector_type(2)));
__device__ __forceinline__ unsigned pkh2(float a, float b) { h2_t h; h.x = (_Float16)a; h.y = (_Float16)b; return __builtin_bit_cast(unsigned, h); }
#define UP_WORD(w) { const unsigned clo = (w) & 0xffffu, chi = (w) << 16; const v2u u = *(const LAS v2u*)(UL + (ghost == 1 ? (unsigned)(X.lane * 8) : (((w) >> 13) & 0x7fff8u))); \
        a0 = dot2bf(u.x, clo, a0); a1 = dot2bf(u.x, chi, a1); a2 = dot2bf(u.y, clo, a2); a3 = dot2bf(u.y, chi, a3); }
#define UP_BLOCK(wv) { _Pragma("unroll") for (int u_ = 0; u_ < 8; ++u_) { UP_WORD(wv[u_].x) UP_WORD(wv[u_].y) UP_WORD(wv[u_].z) UP_WORD(wv[u_].w) } }
#define UP_LOAD(wv, g_) { const int g2_ = ghost == 2 ? 0 : ((g_) < 128 ? (g_) : 127); const unsigned vo_ = (unsigned)((((X.wave + NWAVES * (g2_ >> 2) + trot) & 255) * 32 + (g2_ & 3) * 8) * 64 + X.lane) * 16u; \
        _Pragma("unroll") for (int u_ = 0; u_ < 8; ++u_) wv[u_] = *(const v4u*)(sbase + vo_ + u_ * 1024); }
#define UP_FINISH(g_) { if (((g_) & 3) == 3) { const int t = ((X.wave + NWAVES * ((g_) >> 2) + trot) & 255) * 64 + X.lane, b = t >> 12; \
        const f32x4 xv = *(const f32x4*)(x1 + (size_t)t * DM + cg * 4), gv = *(const f32x4*)(gate_f + (size_t)b * 6144 + cg * 4); \
        f32x4 o; o.x = xv.x + gv.x * a0; o.y = xv.y + gv.y * a1; o.z = xv.z + gv.z * a2; o.w = xv.w + gv.w * a3; \
        *(f32x4*)(x2 + (size_t)t * DM + cg * 4) = o; a0 = 0.f; a1 = 0.f; a2 = 0.f; a3 = 0.f; } }
__device__ __forceinline__ void peer_up_phase(const Ctx& X, const float* e_up_l, const unsigned* STREAM, const float* x1, const float* gate_f, float* x2, int ghost) {
    LAS unsigned char* UL = X.lds;
    const char* sbase = (const char*)STREAM;
    for (int role = X.bid; role < 256; role += X.G) {
        const int cg = (role & 7) * 32 + (role >> 3), trot = (role >> 3);
        if (X.G != 256)
#pragma unroll 1
        for (int e0 = X.tid; e0 < 16384; e0 += NT * 8) {
            f32x4 v[8]; const unsigned vo = (unsigned)(e0 * DM + cg * 4) * 4u;
#pragma unroll
            for (int u = 0; u < 8; ++u) v[u] = *(const f32x4*)((const char*)e_up_l + (size_t)u * NT * DM * 4 + vo);
#pragma unroll
            for (int u = 0; u < 8; ++u) { v2u o; o.x = pk2(v[u].x, v[u].y); o.y = pk2(v[u].z, v[u].w); *(LAS v2u*)(UL + (e0 + u * NT) * 8) = o; }
        }
        __syncthreads();
        float a0 = 0.f, a1 = 0.f, a2 = 0.f, a3 = 0.f;
        v4u wa[8], wb[8];
        UP_LOAD(wa, 0)
#pragma unroll 1
        for (int g = 0; g < 128; g += 2) {
            UP_LOAD(wb, g + 1)
            UP_BLOCK(wa) UP_FINISH(g)
            UP_LOAD(wa, g + 2)
            UP_BLOCK(wb) UP_FINISH(g + 1)
        }
        __syncthreads();
    }
}
#undef UP_WORD
#undef UP_BLOCK
#undef UP_LOAD
#undef UP_FINISH
__device__ __forceinline__ void final_norm_phase(const Ctx& X, const float* xin, const float* g, float* out) {
    const int gw = X.bid * NWAVES + X.wave, NGW = X.G * NWAVES;
    for (int m0 = gw * 2; m0 < M; m0 += NGW * 2) {
        f32x4 v[2][4]; float s[2] = {0.f, 0.f};
#pragma unroll
        for (int e = 0; e < 2; ++e) { const f32x4* xr = (const f32x4*)(xin + (size_t)(m0 + e) * DM) + X.lane;
#pragma unroll
            for (int j = 0; j < 4; ++j) v[e][j] = xr[64 * j]; }
        f32x4 gv[4];
#pragma unroll
        for (int j = 0; j < 4; ++j) gv[j] = *(const f32x4*)(g + 256 * j + 4 * X.lane);
#pragma unroll
        for (int e = 0; e < 2; ++e)
#pragma unroll
            for (int j = 0; j < 4; ++j) s[e] += (v[e][j].x * v[e][j].x + v[e][j].y * v[e][j].y) + (v[e][j].z * v[e][j].z + v[e][j].w * v[e][j].w);
#pragma unroll
        for (int e = 0; e < 2; ++e) { const float rstd = 1.0f / sqrtf(wave_sum(s[e]) * (1.f / DM) + EPS);
            f32x4* o = (f32x4*)(out + (size_t)(m0 + e) * DM) + X.lane;
#pragma unroll
            for (int j = 0; j < 4; ++j) o[64 * j] = (v[e][j] * rstd) * gv[j]; }
    }
}

struct Args { const float* in[23]; float* out; unsigned char* ws; };
#define AS4 __attribute__((address_space(4)))
__device__ __forceinline__ const AS4 Args* kargs() { const AS4 Args* p = (const AS4 Args*)__builtin_amdgcn_kernarg_segment_ptr(); asm volatile("" : "+s"(p)); return p; }
#define KIN(i) (kargs()->in[i])
#define WSP(T, off) ((T*)(kargs()->ws + (off)))
#ifndef REP_CV
#define REP_CV 1
#endif
#ifndef REP_S1
#define REP_S1 1
#endif
#ifndef REP_S3
#define REP_S3 1
#endif
#ifndef REP_R1
#define REP_R1 1
#endif
#ifndef REP_SORT
#define REP_SORT 1
#endif
#ifndef UP_GHOST
#define UP_GHOST 0
#endif
#ifndef DOWN_GHOST
#define DOWN_GHOST 0
#endif
#ifndef REP_DOWN
#define REP_DOWN 1
#endif
#ifndef REP_COMB
#define REP_COMB 1
#endif
#ifndef REP_UP
#define REP_UP 1
#endif
#ifndef REP_N1
#define REP_N1 1
#endif
#ifndef REP_G1
#define REP_G1 1
#endif
#ifndef REP_G2
#define REP_G2 1
#endif
#ifndef REP_N2
#define REP_N2 1
#endif
#ifndef REP_G3
#define REP_G3 1
#endif
#ifndef REP_P0
#define REP_P0 1
#endif
__global__ void __launch_bounds__(NT, 2) fwd_kernel(Args args_unused) {
    extern __shared__ __attribute__((aligned(16))) unsigned char lds_raw[];
    Ctx X; X.lds = (LAS unsigned char*)lds_raw; X.tid = threadIdx.x; X.lane = X.tid & 63; X.wave = __builtin_amdgcn_readfirstlane(X.tid >> 6); X.G = gridDim.x; X.bid = blockIdx.x;
    volatile LAS unsigned* MISC = (volatile LAS unsigned*)(X.lds + MISC_OFF);
    for (int u = X.tid; u < (LDS_BYTES - LDSCTL_OFF) / 4; u += NT) ((LAS unsigned*)(X.lds + LDSCTL_OFF))[u] = 0u;
    __syncthreads();
    XcdBarrier bar = xcd_barrier_post(WSP(unsigned, WS_CTL) + CW_BAR, MISC + 8);
#define GRID_BAR() xcd_barrier(bar)

#ifndef NO_PH_MOD
    for (int _r = 0; _r < REP_P0; ++_r) p0_mod(fresh(X), KIN(1), KIN(2), KIN(3), WSP(float, WS_MOD));
#endif
#ifndef NO_PH_FOLD
    for (int _r = 0; _r < REP_P0; ++_r) p0_fold(fresh(X), KIN(6), KIN(7), WSP(float, WS_WF));
#endif
    for (int l = 0; l < 2; ++l) { p0_cvt(fresh(X), KIN(18) + (size_t)l * 131072, WSP(bf16, WS_KEYS) + (size_t)(l * 2 + 0) * 131072, 131072 / 8); p0_cvt(fresh(X), KIN(19) + (size_t)l * 131072, WSP(bf16, WS_KEYS) + (size_t)(l * 2 + 1) * 131072, 131072 / 8); }
    GRID_BAR();
#ifndef NO_PH_TR
    for (int _r = 0; _r < REP_P0; ++_r) p0_transposes(fresh(X), KIN(6), WSP(float, WS_WF), KIN(16), KIN(17), WSP(bf16, WS_WIN), WSP(bf16, WS_WOUT), WSP(bf16, WS_WQ));
#endif
    __syncthreads();

    for (int l = 0; l < 2; ++l) {
        for (int _r = 0; _r < REP_N1; ++_r) {
            const float* xin = (l == 0) ? KIN(0) : WSP(float, WS_X2); const float* modl = WSP(float, WS_MOD) + (size_t)l * 4 * 6144;
            norm_mod_phase(fresh(X), xin, KIN(4) + l * DM, modl + 0 * DM, modl + 1 * DM, WSP(bf16, WS_XN));
        }
        GRID_BAR();
        for (int _r = 0; _r < REP_G1; ++_r) {
            pg8::Gemm g{WSP(bf16, WS_XN), WSP(bf16, WS_WIN) + (size_t)l * NPROJ_PAD * 1024, M, PROJ_LD, DM}; const Ctx Y = fresh(X); pg8::StaticOrder S; S.init(M, PROJ_LD, Y.G, Y.bid);
            pg8::EpiStore E{WSP(bf16, WS_PROJ), PROJ_LD, 12, WSP(float, WS_DTRAW), 16, 16};
            pg8::gemm_phase<pg8::EpiStore, pg8::StaticOrder, true, true>(X.lds, g, S, E);
            dt_proj_phase(fresh(X), WSP(bf16, WS_XN), WSP(bf16, WS_WIN) + (size_t)l * NPROJ_PAD * 1024, WSP(float, WS_DTRAW));
        }
        GRID_BAR();
        for (int _r = 0; _r < REP_S1; ++_r) ssd_a_phase(fresh(X), kargs()->ws, KIN(10) + (size_t)l * 4 * 1536, KIN(11) + (size_t)l * 1536, KIN(12) + l * 16, KIN(13) + l * 16);
        GRID_BAR();
#ifndef NO_PH_S2
        ssd_scan_phase(fresh(X), WSP(bf16, WS_ST), WSP(float, WS_CD));
#endif
        GRID_BAR();
        for (int _r = 0; _r < REP_S3; ++_r) ssd_c_phase(fresh(X), kargs()->ws, KIN(14) + l * 16);
        GRID_BAR();
#ifndef NO_PH_S4
        mix_finish_phase(fresh(X), WSP(bf16, WS_PROJ), WSP(float, WS_SSQ), KIN(15) + l * DM, KIN(8) + l * 512, KIN(9) + l * 512, WSP(bf16, WS_XN));
#endif
        GRID_BAR();
        for (int _r = 0; _r < REP_G2; ++_r) {
            const float* xin = (l == 0) ? KIN(0) : WSP(float, WS_X2);
            pg8::Gemm g{WSP(bf16, WS_XN), WSP(bf16, WS_WOUT) + (size_t)l * 1024 * NMIX, M, DM, NMIX}; const Ctx Y = fresh(X); pg8::StaticOrder S; S.init(M, DM, Y.G, Y.bid);
            pg8::EpiResid E{xin, kargs()->out, WSP(float, WS_MOD) + (size_t)l * 4 * 6144 + 2 * DM};
            pg8::gemm_phase<pg8::EpiResid, pg8::StaticOrder, true, true>(X.lds, g, S, E);
        }
        GRID_BAR();
        for (int _r = 0; _r < REP_N2; ++_r) {
            const float* modl = WSP(float, WS_MOD) + (size_t)l * 4 * 6144;
            norm_mod_phase(fresh(X), kargs()->out, KIN(5) + l * DM, modl + 3 * DM, modl + 4 * DM, WSP(bf16, WS_XN));
        }
        GRID_BAR();
        for (int _r = 0; _r < REP_G3; ++_r) {
            pg8::Gemm g{WSP(bf16, WS_XN), WSP(bf16, WS_WQ) + (size_t)l * NQ * 1024, M, NQ, DM}; const Ctx Y = fresh(X); pg8::StaticOrder S; S.init(M, NQ, Y.G, Y.bid);
            pg8::EpiStore E{WSP(bf16, WS_PROJ), NQ, 1 << 30, nullptr, 0, 0};
            pg8::gemm_phase<pg8::EpiStore, pg8::StaticOrder, true, true>(X.lds, g, S, E);
        }
        GRID_BAR();
#ifndef NO_PH_R1
        for (int _r = 0; _r < REP_R1; ++_r) route_phase(fresh(X), WSP(bf16, WS_PROJ), WSP(bf16, WS_KEYS) + (size_t)l * 2 * 131072, WSP(int, WS_IDX), WSP(float, WS_GATE));
#endif
        GRID_BAR();
        for (int _r = 0; _r < REP_SORT; ++_r) peer_sort_phase(fresh(X), WSP(int, WS_IDX), WSP(float, WS_GATE), WSP(int, WS_ENT), WSP(float, WS_GS), WSP(unsigned short, WS_OFF));
        GRID_BAR();
        for (int _r = 0; _r < REP_DOWN; ++_r) peer_down_phase(fresh(X), KIN(20) + (size_t)l * 16384 * 1024, WSP(bf16, WS_XN), WSP(int, WS_ENT), WSP(unsigned short, WS_OFF), WSP(unsigned, WS_LIST), WSP(float, WS_PART), _r == 0 ? 0 : DOWN_GHOST);
        GRID_BAR();
        for (int _r = 0; _r < REP_COMB; ++_r) peer_combine_phase(fresh(X), WSP(float, WS_PART), WSP(float, WS_GS), WSP(int, WS_ENT), WSP(unsigned, WS_STREAM), KIN(21) + (size_t)l * 16384 * 1024);
        GRID_BAR();
        for (int _r = 0; _r < REP_UP; ++_r) peer_up_phase(fresh(X), KIN(21) + (size_t)l * 16384 * 1024, WSP(unsigned, WS_STREAM), kargs()->out, WSP(float, WS_MOD) + (size_t)l * 4 * 6144 + 5 * DM, _r == 0 ? WSP(float, WS_X2) : WSP(float, WS_PART), _r == 0 ? 0 : UP_GHOST);
        GRID_BAR();
#ifdef EXTRA_BARS
        for (int _e = 0; _e < EXTRA_BARS; ++_e) GRID_BAR();
#endif
        if (l == 1) final_norm_phase(fresh(X), WSP(float, WS_X2), KIN(22), kargs()->out);
    }
}

extern "C" void kernel_launch(void* const* d_in, const int* in_sizes, int n_in, void* d_out, int out_size, void* d_ws, size_t ws_size, hipStream_t stream) {
    static int grid = 0;
    if (grid == 0) {
        if (n_in != 23 || out_size != M * DM || ws_size < WS_END) { fprintf(stderr, "kernel_launch: unexpected shapes (n_in %d, out %d, ws %zu); nothing launched\n", n_in, out_size, ws_size); grid = -1; return; }
        int dev = 0, cus = 0, per_cu = 0;
        if (hipGetDevice(&dev) != hipSuccess || hipDeviceGetAttribute(&cus, hipDeviceAttributeMultiprocessorCount, dev) != hipSuccess) { grid = -1; return; }
        if (hipFuncSetAttribute((const void*)fwd_kernel, hipFuncAttributeMaxDynamicSharedMemorySize, LDS_BYTES) != hipSuccess) { fprintf(stderr, "kernel_launch: hipFuncSetAttribute failed\n"); grid = -1; return; }
        if (hipOccupancyMaxActiveBlocksPerMultiprocessor(&per_cu, (const void*)fwd_kernel, NT, LDS_BYTES) != hipSuccess || per_cu < 1) { fprintf(stderr, "kernel_launch: occupancy query says %d\n", per_cu); }
        (void)hipGetLastError();
        grid = cus;
    }
    if (grid < 0) return;
    if (hipMemsetAsync((char*)d_ws + WS_CTL, 0, CTL_ZERO_BYTES, stream) != hipSuccess) { fprintf(stderr, "kernel_launch: memset failed\n"); return; }
    Args a{};
    for (int i = 0; i < 23; ++i) a.in[i] = (const float*)d_in[i];
    a.out = (float*)d_out; a.ws = (unsigned char*)d_ws;
    hipLaunchKernelGGL(fwd_kernel, dim3(grid), dim3(NT), LDS_BYTES, stream, a);
}
```

```cpp
#include <hip/hip_runtime.h>
#include <cstdio>
#include <cstdint>
namespace pg8 {
#define PG8_LAS __attribute__((address_space(3)))
typedef unsigned short bf16_t;
typedef short bf16x8 __attribute__((ext_vector_type(8)));
typedef float f32x4 __attribute__((ext_vector_type(4)));
typedef unsigned u32x4 __attribute__((ext_vector_type(4)));
constexpr int BM = 256, BK = 64, HALF = 128, HTB = HALF * BK * 2  , STAGE_BYTES = 8 * HTB, NXCD = 8, WGM = 8;

__host__ __device__ __forceinline__ int lds_byte(int r, int c) { const int st = (r >> 4) * 2 + (c >> 5), rr = r & 15, cc = c & 31, ob = rr * 64 + cc * 2; return st * 1024 + (ob ^ (((ob >> 9) & 1) << 5)); }
__host__ __device__ __forceinline__ void stage_rc(int b, int& R, int& C) { const int st = b / 1024, sb = b % 1024, swz = sb ^ (((sb >> 9) & 1) << 5); R = (st >> 1) * 16 + swz / 64; C = (st & 1) * 32 + (swz % 64) / 2; }
__host__ __device__ __forceinline__ int perm32(int rho) { const int n = rho >> 4, i = rho & 15; return 8 * (i >> 2) + 4 * n + (i & 3); }

struct Unit { int pm, pn; };
struct Gemm { const bf16_t* A; const bf16_t* Bt; int M, N, K; };

struct StaticOrder {
    int nM, nN, nwg, G, c;
    __host__ __device__ void init(int M, int N, int G_, int c_) { nM = M / BM; nN = N / BM; nwg = nM * nN; G = G_; c = c_; }
    __host__ __device__ bool next(int i, Unit& u) const {
        const long L = (long)i * G + c; if (L >= nwg) return false;
        int wgid = (int)L; { const int q = nwg / NXCD, r = nwg % NXCD, xcd = wgid % NXCD, off = wgid / NXCD; wgid = (xcd < r ? xcd * (q + 1) : r * (q + 1) + (xcd - r) * q) + off; }
        const int nig = WGM * nN, gid = wgid / nig, fm = gid * WGM, gsz = (nM - fm) < WGM ? (nM - fm) : WGM;
        u.pm = fm + ((wgid % nig) % gsz); u.pn = (wgid % nig) / gsz; return true;
    }
    __device__ __forceinline__ void a_ready(const Unit&) const {}
    __device__ __forceinline__ void done(const Unit&) const {}
};


__device__ __forceinline__ unsigned cvt_pk_bf16(float lo, float hi) { unsigned r; asm volatile("v_cvt_pk_bf16_f32 %0, %1, %2" : "=v"(r) : "v"(lo), "v"(hi)); return r; }

struct EpiStore {
    static constexpr bool PERM = true, AFTER_DRAIN = false;
    bf16_t* O; int ldc; int pn_f32; float* F32; int ld32; int ncol32;
    __device__ __forceinline__ void operator()(const f32x4 (&acc)[2][2][4][2], const Unit& u, int wr, int wc, int fr, int fq) const {
        const int row0 = u.pm * BM + wr * 64 + fr;
        if (u.pn >= pn_f32) {
#pragma unroll
            for (int ai = 0; ai < 2; ++ai)
#pragma unroll
                for (int m = 0; m < 4; ++m) { const size_t row = (size_t)(row0 + ai * HALF + m * 16);
#pragma unroll
                    for (int bj = 0; bj < 2; ++bj)
#pragma unroll
                        for (int n = 0; n < 2; ++n) { const int c0 = bj * HALF + wc * 32 + 8 * fq + 4 * n;
#pragma unroll
                            for (int j = 0; j < 4; ++j) if (c0 + j < ncol32) F32[row * ld32 + c0 + j] = acc[ai][bj][m][n][j]; } }
            return;
        }
        const int col0 = u.pn * BM + wc * 32 + 8 * fq;
#pragma unroll
        for (int ai = 0; ai < 2; ++ai)
#pragma unroll
            for (int m = 0; m < 4; ++m) { bf16_t* rowp = O + (size_t)(row0 + ai * HALF + m * 16) * ldc + col0;
#pragma unroll
                for (int bj = 0; bj < 2; ++bj) { const f32x4 v0 = acc[ai][bj][m][0], v1 = acc[ai][bj][m][1];
                    u32x4 w; w.x = cvt_pk_bf16(v0[0], v0[1]); w.y = cvt_pk_bf16(v0[2], v0[3]); w.z = cvt_pk_bf16(v1[0], v1[1]); w.w = cvt_pk_bf16(v1[2], v1[3]);
                    *(u32x4*)(rowp + bj * HALF) = w; } }
    }
};

struct EpiResid {
    static constexpr bool PERM = false, AFTER_DRAIN = false;
    const float* xin; float* out; const float* gate;
    __device__ __forceinline__ void operator()(const f32x4 (&acc)[2][2][4][2], const Unit& u, int wr, int wc, int fr, int fq) const {
        const int col0 = u.pn * BM + wc * 32 + 4 * fq;
#pragma unroll
        for (int ai = 0; ai < 2; ++ai)
#pragma unroll
            for (int m = 0; m < 4; ++m) { const int row = u.pm * BM + ai * HALF + wr * 64 + m * 16 + fr; const int b = row >> 12; const size_t off = (size_t)row * 1024 + col0;
#pragma unroll
                for (int bj = 0; bj < 2; ++bj)
#pragma unroll
                    for (int n = 0; n < 2; ++n) { const int cc = bj * HALF + n * 16;
                        const f32x4 g = *(const f32x4*)(gate + (size_t)b * 6144 + col0 + cc); const f32x4 x = *(const f32x4*)(xin + off + cc);
                        *(f32x4*)(out + off + cc) = x + g * acc[ai][bj][m][n]; } }
    }
};
template <class Epi, class Sched, bool ALIGN_EPI = false, bool SP2 = false>
__device__ __forceinline__ void gemm_phase(PG8_LAS unsigned char* lds, const Gemm g, const Sched& S, const Epi& E) {
    int tid_ = threadIdx.x; asm volatile("" : "+v"(tid_));
    const int tid = tid_, wid = __builtin_amdgcn_readfirstlane(tid >> 6), lane = tid & 63, wr = wid >> 2, wc = wid & 3, fr = lane & 15, fq = lane >> 4;
    const int K = g.K, nt = K / BK;
    unsigned voffA[2], voffB[2];
#pragma unroll
    for (int i = 0; i < 2; ++i) { int R, C; stage_rc(tid * 16 + i * 8192, R, C); const int Rb = Epi::PERM ? ((R & ~31) + perm32(R & 31)) : R;
        voffA[i] = (unsigned)(R * K + C) * 2u; voffB[i] = (unsigned)(Rb * K + C) * 2u; }
    const size_t kstep = (size_t)(BK * 2);
    const size_t hstep = (size_t)HALF * K * 2;
    const size_t tstep = 2 * hstep;
    const unsigned ldsw = (unsigned)wid * 1024u;
    const int aoff = lds_byte(wr * 64 + fr, fq * 8), boff = lds_byte(wc * 32 + fr, fq * 8);
#define PG8_SA(b, h) (((b) * 2 + (h)) * HTB)
#define PG8_SB(b, h) ((4 + (b) * 2 + (h)) * HTB)
#define PG8_STAGE(bufoff, gbase, voff) do { _Pragma("unroll") for (int _i = 0; _i < 2; ++_i) \
        __builtin_amdgcn_global_load_lds((const unsigned*)((const char*)(gbase) + (voff)[_i]), (PG8_LAS unsigned*)(lds + (bufoff) + ldsw + _i * 8192), 16, 0, 0); } while (0)
#define PG8_LDA(dst, b, h) do { _Pragma("unroll") for (int m = 0; m < 4; ++m) _Pragma("unroll") for (int k = 0; k < 2; ++k) dst[m][k] = *(const PG8_LAS bf16x8*)(lds + PG8_SA(b, h) + aoff + m * 2048 + k * 1024); } while (0)
#define PG8_LDB(dst, b, h) do { _Pragma("unroll") for (int n = 0; n < 2; ++n) _Pragma("unroll") for (int k = 0; k < 2; ++k) dst[n][k] = *(const PG8_LAS bf16x8*)(lds + PG8_SB(b, h) + boff + n * 2048 + k * 1024); } while (0)
#define PG8_MMA(ai, bj, At, Bt) do { __builtin_amdgcn_s_setprio(1); _Pragma("unroll") for (int m = 0; m < 4; ++m) _Pragma("unroll") for (int n = 0; n < 2; ++n) _Pragma("unroll") for (int k = 0; k < 2; ++k) \
        acc[ai][bj][m][n] = __builtin_amdgcn_mfma_f32_16x16x32_bf16(Bt[n][k], At[m][k], acc[ai][bj][m][n], 0, 0, 0); __builtin_amdgcn_s_setprio(0); } while (0)
#define PG8_WAIT_V(n) asm volatile("s_waitcnt vmcnt(" #n ")" ::: "memory")
#define PG8_WAIT_L(n) asm volatile("s_waitcnt lgkmcnt(" #n ")" ::: "memory")
#define PG8_BAR __builtin_amdgcn_s_barrier()
#define PG8_SCHED __builtin_amdgcn_sched_barrier(0)
    Unit cur, nxt; int ui = 0;
    if (!S.next(0, cur)) return;
    f32x4 acc[2][2][4][2];
#pragma unroll
    for (int a = 0; a < 2; ++a)
#pragma unroll
        for (int b = 0; b < 2; ++b)
#pragma unroll
            for (int m = 0; m < 4; ++m)
#pragma unroll
                for (int n = 0; n < 2; ++n) acc[a][b][m][n] = (f32x4){0.f, 0.f, 0.f, 0.f};
    bf16x8 At[4][2], B0[2][2], B1[2][2];
    const char* cA = (const char*)g.A + (size_t)cur.pm * tstep; const char* cB = (const char*)g.Bt + (size_t)cur.pn * tstep;
    S.a_ready(cur);
    if constexpr (SP2) {
        PG8_STAGE(PG8_SB(0, 0), cB, voffB); PG8_STAGE(PG8_SB(0, 1), cB + hstep, voffB); PG8_STAGE(PG8_SA(0, 0), cA, voffA); PG8_STAGE(PG8_SA(0, 1), cA + hstep, voffA);
        if (wr == 1) PG8_BAR;
        PG8_WAIT_V(2); PG8_BAR;
        PG8_STAGE(PG8_SB(1, 0), cB + kstep, voffB); PG8_STAGE(PG8_SA(1, 0), cA + kstep, voffA); PG8_STAGE(PG8_SB(1, 1), cB + hstep + kstep, voffB);
        PG8_WAIT_V(6); PG8_BAR;
    } else {
        PG8_STAGE(PG8_SB(0, 0), cB, voffB); PG8_STAGE(PG8_SA(0, 0), cA, voffA); PG8_STAGE(PG8_SB(0, 1), cB + hstep, voffB); PG8_STAGE(PG8_SA(0, 1), cA + hstep, voffA);
        if (wr == 1) PG8_BAR;
        PG8_WAIT_V(4); PG8_BAR;
        PG8_STAGE(PG8_SB(1, 0), cB + kstep, voffB); PG8_STAGE(PG8_SA(1, 0), cA + kstep, voffA); PG8_STAGE(PG8_SB(1, 1), cB + hstep + kstep, voffB);
        PG8_WAIT_V(6); PG8_BAR;
    }
    for (;;) {
        const bool has_next = S.next(ui + 1, nxt);
        const char* nA = has_next ? (const char*)g.A + (size_t)nxt.pm * tstep : cA; const char* nB = has_next ? (const char*)g.Bt + (size_t)nxt.pn * tstep : cB;
        for (int t = 0; t < nt; t += 2) {
            const bool last = (t == nt - 2);
            const char* a1 = cA + (size_t)(t + 1) * kstep;
            const char* a2 = last ? nA : cA + (size_t)(t + 2) * kstep; const char* b2 = last ? nB : cB + (size_t)(t + 2) * kstep;
            const char* a3 = a2 + kstep; const char* b3 = b2 + kstep;
            if (last && has_next) S.a_ready(nxt);
            if constexpr (SP2) {
            PG8_LDB(B0, 0, 0); PG8_LDB(B1, 0, 1); PG8_SCHED; PG8_LDA(At, 0, 0); PG8_STAGE(PG8_SA(1, 1), a1 + hstep, voffA);
            PG8_WAIT_V(8); PG8_WAIT_L(0); PG8_BAR; PG8_MMA(0, 0, At, B0); PG8_MMA(0, 1, At, B1); PG8_BAR; PG8_SCHED;
            PG8_LDA(At, 0, 1); PG8_STAGE(PG8_SB(0, 0), b2, voffB); PG8_STAGE(PG8_SB(0, 1), b2 + hstep, voffB); PG8_STAGE(PG8_SA(0, 0), a2, voffA);
            PG8_WAIT_V(8); PG8_WAIT_L(0); PG8_BAR; PG8_MMA(1, 0, At, B0); PG8_MMA(1, 1, At, B1); PG8_BAR; PG8_SCHED;
            PG8_LDB(B0, 1, 0); PG8_LDB(B1, 1, 1); PG8_SCHED; PG8_LDA(At, 1, 0); PG8_STAGE(PG8_SA(0, 1), a2 + hstep, voffA);
            PG8_WAIT_V(8); PG8_WAIT_L(0); PG8_BAR; PG8_MMA(0, 0, At, B0); PG8_MMA(0, 1, At, B1); PG8_BAR; PG8_SCHED;
            PG8_LDA(At, 1, 1); PG8_STAGE(PG8_SB(1, 0), b3, voffB); PG8_STAGE(PG8_SB(1, 1), b3 + hstep, voffB); PG8_STAGE(PG8_SA(1, 0), a3, voffA);
            PG8_WAIT_V(8); PG8_WAIT_L(0); PG8_BAR; PG8_MMA(1, 0, At, B0); PG8_MMA(1, 1, At, B1); PG8_BAR; PG8_SCHED;
            } else {
            PG8_LDB(B0, 0, 0); PG8_SCHED; PG8_LDA(At, 0, 0); PG8_STAGE(PG8_SA(1, 1), a1 + hstep, voffA);
            PG8_WAIT_L(8); PG8_BAR; PG8_WAIT_L(0); PG8_MMA(0, 0, At, B0); PG8_BAR; PG8_SCHED;
            PG8_LDB(B1, 0, 1); PG8_STAGE(PG8_SB(0, 0), b2, voffB);
            PG8_BAR; PG8_WAIT_L(0); PG8_MMA(0, 1, At, B1); PG8_BAR;
            PG8_LDA(At, 0, 1); PG8_STAGE(PG8_SA(0, 0), a2, voffA);
            PG8_BAR; PG8_WAIT_L(0); PG8_MMA(1, 0, At, B0); PG8_BAR; PG8_SCHED;
            PG8_STAGE(PG8_SB(0, 1), b2 + hstep, voffB);
            PG8_WAIT_V(6); PG8_BAR; PG8_MMA(1, 1, At, B1); PG8_BAR;
            PG8_LDB(B0, 1, 0); PG8_SCHED; PG8_LDA(At, 1, 0); PG8_STAGE(PG8_SA(0, 1), a2 + hstep, voffA);
            PG8_WAIT_L(8); PG8_BAR; PG8_WAIT_L(0); PG8_MMA(0, 0, At, B0); PG8_BAR; PG8_SCHED;
            PG8_LDB(B1, 1, 1); PG8_STAGE(PG8_SB(1, 0), b3, voffB);
            PG8_BAR; PG8_WAIT_L(0); PG8_MMA(0, 1, At, B1); PG8_BAR;
            PG8_LDA(At, 1, 1); PG8_STAGE(PG8_SA(1, 0), a3, voffA);
            PG8_BAR; PG8_WAIT_L(0); PG8_MMA(1, 0, At, B0); PG8_BAR; PG8_SCHED;
            PG8_STAGE(PG8_SB(1, 1), b3 + hstep, voffB);
            PG8_WAIT_V(6); PG8_BAR; PG8_MMA(1, 1, At, B1); PG8_BAR;
            }
        }
        if constexpr (ALIGN_EPI) { if (wr == 0) PG8_BAR; }
        if constexpr (!Epi::AFTER_DRAIN) { E(acc, cur, wr, wc, fr, fq); S.done(cur); }
        if (!has_next) break;
#pragma unroll
        for (int a = 0; a < 2; ++a)
#pragma unroll
            for (int b = 0; b < 2; ++b)
#pragma unroll
                for (int m = 0; m < 4; ++m)
#pragma unroll
                    for (int n = 0; n < 2; ++n) acc[a][b][m][n] = (f32x4){0.f, 0.f, 0.f, 0.f};
        cur = nxt; cA = nA; cB = nB; ++ui;
        if constexpr (ALIGN_EPI) { if (wr == 1) PG8_BAR; }
    }
    PG8_WAIT_V(0);
    if constexpr (!ALIGN_EPI) { if (wr == 0) PG8_BAR; }
    PG8_BAR;
    if constexpr (Epi::AFTER_DRAIN) { E.fused(acc, cur, wr, wc, fr, fq, lds, wid, lane); S.done(cur); }
#undef PG8_SA
#undef PG8_SB
#undef PG8_STAGE
#undef PG8_LDA
#undef PG8_LDB
#undef PG8_MMA
#undef PG8_WAIT_V
#undef PG8_WAIT_L
#undef PG8_BAR
#undef PG8_SCHED
}
}
#define GAS __attribute__((address_space(1)))
#define LAS __attribute__((address_space(3)))
typedef unsigned short bf16;
typedef unsigned v4u __attribute__((ext_vector_type(4)));
typedef float f32x4 __attribute__((ext_vector_type(4)));
typedef short bf16x8 __attribute__((ext_vector_type(8)));
typedef GAS unsigned gu32;
typedef GAS unsigned long long gu64;
#define RLX_AGENT __ATOMIC_RELAXED, __HIP_MEMORY_SCOPE_AGENT
#define LDS_WAIT() asm volatile("s_waitcnt lgkmcnt(0)" ::: "memory")
#define VM_WAIT() asm volatile("s_waitcnt vmcnt(0)" ::: "memory")
__device__ __forceinline__ unsigned long long rt() { return __builtin_amdgcn_s_memrealtime(); }
__device__ __forceinline__ unsigned f2bf(float f) { unsigned u = __builtin_bit_cast(unsigned, f); return (u + 0x7fffu + ((u >> 16) & 1u)) >> 16; }
__device__ __forceinline__ unsigned pk2(float lo, float hi) { return f2bf(lo) | (f2bf(hi) << 16); }

#define XB_TMO      128
#define XB_XCNT(j)  (256  + 64 * (j))
#define XB_XSUB(j)  (1280 + 64 * (j))
#define XB_XGEN(j)  (2304 + 64 * (j))
#define XB_TOP      3328
#define XB_TOPGEN   3392
#define XCD_BAR_WORDS 3456
#define XB_SPIN_CAP (1u << 18)

__device__ __forceinline__ unsigned xb_ld(unsigned* p)              { return __hip_atomic_load(p, __ATOMIC_RELAXED, __HIP_MEMORY_SCOPE_AGENT); }
__device__ __forceinline__ unsigned xb_add(unsigned* p, unsigned v) { return __hip_atomic_fetch_add(p, v, __ATOMIC_RELAXED, __HIP_MEMORY_SCOPE_AGENT); }
__device__ __forceinline__ unsigned xb_xcc_id() { return (unsigned)__builtin_amdgcn_s_getreg((3 << 11) | 20) & 0xFu; }
#define XB_SPIN(cond, bar) do { unsigned _sp = 0; while (cond) { __builtin_amdgcn_s_sleep(1); \
    if ((++_sp & 255u) == 0u) { if (xb_ld(&(bar)[XB_TMO])) break; if (_sp > XB_SPIN_CAP) { atomicAdd(&(bar)[XB_TMO], 1u); break; } } } } while (0)

struct XcdBarrier {
    unsigned* bar; unsigned x;
    volatile LAS unsigned* st;
};

__device__ __forceinline__ XcdBarrier xcd_barrier_post(unsigned* bar, volatile LAS unsigned* st) {
    XcdBarrier b; b.bar = bar; b.x = xb_xcc_id(); b.st = st;
    if (threadIdx.x == 0) (void)xb_add(&bar[XB_XCNT(b.x)], 1u);
    return b;
}
__device__ __forceinline__ void xcd_barrier_complete(unsigned* bar, unsigned x, unsigned& nloc, unsigned& nx) {
    const unsigned G = gridDim.x * gridDim.y * gridDim.z;
    unsigned sum, cnt, mine, sp = 0u;
    for (;;) {
        sum = 0u; cnt = 0u; mine = 0u;
#pragma unroll
        for (unsigned j = 0; j < 16; ++j) { const unsigned c = xb_ld(&bar[XB_XCNT(j)]); sum += c; cnt += (c > 0u) ? 1u : 0u; mine = (j == x) ? c : mine; }
        if (sum == G) break;
        __builtin_amdgcn_s_sleep(1);
        if ((++sp & 255u) == 0u) { if (xb_ld(&bar[XB_TMO])) break; if (sp > XB_SPIN_CAP) { atomicAdd(&bar[XB_TMO], 1u); break; } }
    }
    nloc = mine > 0u ? mine : 1u; nx = cnt > 0u ? cnt : 1u;
}

__device__ __forceinline__ void xcd_barrier(const XcdBarrier& b) {
    asm volatile("s_waitcnt vmcnt(0)" ::: "memory");
    __syncthreads();
    if (threadIdx.x == 0) {
        unsigned* bar = b.bar;
        __builtin_amdgcn_s_waitcnt(0);
        unsigned nloc = b.st[0], nx = b.st[1];
        if (nloc == 0u) { xcd_barrier_complete(bar, b.x, nloc, nx); b.st[0] = nloc; b.st[1] = nx; }
        const unsigned old = xb_add(&bar[XB_XSUB(b.x)], 1u);
        const unsigned gen = old / nloc;
        if (old + 1u == (gen + 1u) * nloc) {
            __builtin_amdgcn_fence(__ATOMIC_RELEASE, "agent");
            asm volatile("s_waitcnt vmcnt(0)" ::: "memory");
            const unsigned og = xb_add(&bar[XB_TOP], 1u);
            const unsigned tg = og / nx;
            if (og + 1u == (tg + 1u) * nx) xb_add(&bar[XB_TOPGEN], 1u);
            else XB_SPIN(xb_ld(&bar[XB_TOPGEN]) == tg, bar);
            __builtin_amdgcn_fence(__ATOMIC_ACQUIRE, "agent");
            xb_add(&bar[XB_XGEN(b.x)], 1u);
            asm volatile("s_waitcnt vmcnt(0)" ::: "memory");
        } else {
            XB_SPIN(xb_ld(&bar[XB_XGEN(b.x)]) == gen, bar);
            __builtin_amdgcn_fence(__ATOMIC_ACQUIRE, "agent");
            asm volatile("s_waitcnt vmcnt(0)" ::: "memory");
        }
    }
    __syncthreads();
}

constexpr int NWAVES = 8, NT = 512;
constexpr int BATCH = 4, SEQ = 4096, DM = 1024, M = BATCH * SEQ;
constexpr int NPROJ = 3088, NPROJ_PAD = 3328, PROJ_LD = 3072, NMIX = 1536, NQ = 2048;
constexpr int NBC = M / 128;
constexpr float EPS = 1e-6f;
typedef float f32x16 __attribute__((ext_vector_type(16)));
typedef unsigned v2u __attribute__((ext_vector_type(2)));

constexpr size_t MiB = 1u << 20;
constexpr size_t WS_CTL = 0, CTL_ZERO_BYTES = 64 * 1024;
constexpr size_t WS_MOD = 1 * MiB, WS_KEYS = 2 * MiB, WS_CD = 3 * MiB;
constexpr size_t WS_WIN = 4 * MiB, WS_WOUT = 17 * MiB, WS_WQ = 23 * MiB;
constexpr size_t WS_PART = 32 * MiB, WS_ENT = 96 * MiB, WS_GS = 104 * MiB, WS_OFF = 112 * MiB, WS_STREAM = 113 * MiB, WS_LIST = 121 * MiB;
constexpr size_t WS_XN = 160 * MiB;
constexpr size_t WS_PROJ = 208 * MiB;
constexpr size_t WS_ST = 304 * MiB;
constexpr size_t WS_X2 = 336 * MiB;
constexpr size_t WS_CBC = 400 * MiB;
constexpr size_t WS_XBT = 416 * MiB;
constexpr size_t WS_WF = 456 * MiB;
constexpr size_t WS_DTRAW = 460 * MiB, WS_DTV = 461 * MiB, WS_ACS = 462 * MiB, WS_SSQ = 463 * MiB;
constexpr size_t WS_IDX = 464 * MiB, WS_GATE = 472 * MiB;
constexpr size_t WS_END = 480 * MiB;
constexpr int CW_BAR = 1024;
static_assert((CW_BAR + XCD_BAR_WORDS) * 4 <= (int)CTL_ZERO_BYTES, "ctl");

constexpr int RING_BYTES = 131072, LDS_BYTES = 163840, LDSCTL_OFF = LDS_BYTES - 512, MISC_OFF = LDSCTL_OFF + 320;

__device__ __forceinline__ float bflo(unsigned w) { return __uint_as_float(w << 16); }
__device__ __forceinline__ float bfhi(unsigned w) { return __uint_as_float(w & 0xffff0000u); }
__device__ __forceinline__ float bf2f(unsigned short h) { return __uint_as_float(((unsigned)h) << 16); }
__device__ __forceinline__ float siluf(float x) { return x / (1.f + __expf(-x)); }
__device__ __forceinline__ float wave_sum(float v) {
#pragma unroll
    for (int o = 1; o < 64; o <<= 1) v += __shfl_xor(v, o);
    return v;
}
__device__ __forceinline__ int rowoff(int reg, int h) { return (reg & 3) + 8 * (reg >> 2) + 4 * h; }
#define MFMA32(a, b, c) __builtin_amdgcn_mfma_f32_32x32x16_bf16((a), (b), (c), 0, 0, 0)
#define LDS_BARRIER() do { asm volatile("s_waitcnt lgkmcnt(0)" ::: "memory"); __builtin_amdgcn_s_barrier(); asm volatile("" ::: "memory"); } while (0)
#define DPP_ADD(v, ctrl) ((v) + __int_as_float(__builtin_amdgcn_update_dpp(0, __float_as_int(v), (ctrl), 0xF, 0xF, true)))

struct Ctx { LAS unsigned char* lds; int tid, lane, wave, G, bid; };
__device__ __forceinline__ Ctx fresh(const Ctx& X) { Ctx Y; Y.lds = X.lds; int t = X.tid; asm volatile("" : "+v"(t)); int g = X.G, b = X.bid; asm volatile("" : "+s"(g), "+s"(b)); Y.tid = t; Y.lane = t & 63; Y.wave = __builtin_amdgcn_readfirstlane(t >> 6); Y.G = g; Y.bid = b; return Y; }

__device__ __forceinline__ void p0_mod(const Ctx& X, const float* c, const float* w_ada, const float* b_ada, float* MOD) {
    LAS float* cs = (LAS float*)X.lds; LAS float* red = (LAS float*)(X.lds + 16384);
    for (int i = X.tid; i < 4096; i += NT) cs[i] = siluf(c[i]);
    __syncthreads();
    for (int item = X.bid; item < 192; item += X.G) {
        const int l = item / 96, cc = item % 96, col = cc * 64 + X.lane;
        const float* W = w_ada + (size_t)l * 1024 * 6144 + col;
        float a0 = 0.f, a1 = 0.f, a2 = 0.f, a3 = 0.f;
#pragma unroll 16
        for (int kk = 0; kk < 128; ++kk) { const int k = X.wave * 128 + kk; const float w = W[(size_t)k * 6144];
            a0 += cs[k] * w; a1 += cs[1024 + k] * w; a2 += cs[2048 + k] * w; a3 += cs[3072 + k] * w; }
        red[(X.wave * 4 + 0) * 64 + X.lane] = a0; red[(X.wave * 4 + 1) * 64 + X.lane] = a1; red[(X.wave * 4 + 2) * 64 + X.lane] = a2; red[(X.wave * 4 + 3) * 64 + X.lane] = a3;
        __syncthreads();
        if (X.tid < 256) { const int b = X.tid >> 6, ln = X.tid & 63; float s = 0.f;
#pragma unroll
            for (int w = 0; w < 8; ++w) s += red[(w * 4 + b) * 64 + ln];
            MOD[((size_t)l * 4 + b) * 6144 + cc * 64 + ln] = s + b_ada[(size_t)l * 6144 + cc * 64 + ln]; }
        __syncthreads();
    }
}
__device__ __forceinline__ void p0_fold(const Ctx& X, const float* w_in, const float* pool_w, float* WF) {
    const int gt = X.bid * NT + X.tid, GT = X.G * NT;
    for (int o = gt; o < 2 * 4 * 128 * 128; o += GT) {
        const int d = o & 127, kb = (o >> 7) & 127, g = (o >> 14) & 3, l = o >> 16;
        const float* wi = w_in + ((size_t)l * 1024 + kb * 8) * NPROJ + g * 128;
        const float* pw = pool_w + ((size_t)(l * 4 + g) * 128) * 128 + d;
        float acc[8] = {0.f, 0.f, 0.f, 0.f, 0.f, 0.f, 0.f, 0.f};
#pragma unroll 4
        for (int c = 0; c < 128; ++c) { const float p = pw[(size_t)c * 128];
#pragma unroll
            for (int i = 0; i < 8; ++i) acc[i] += wi[(size_t)i * NPROJ + c] * p; }
#pragma unroll
        for (int i = 0; i < 8; ++i) WF[((size_t)l * 1024 + kb * 8 + i) * 512 + g * 128 + d] = acc[i];
    }
}
__device__ __forceinline__ void p0_cvt(const Ctx& X, const float* src, bf16* dst, size_t n8) {
    const size_t gt = (size_t)X.bid * NT + X.tid, GT = (size_t)X.G * NT;
    for (size_t i = gt; i < n8; i += GT) {
        const f32x4 a = ((const f32x4*)src)[2 * i], b = ((const f32x4*)src)[2 * i + 1];
        v4u o; o.x = pk2(a.x, a.y); o.y = pk2(a.z, a.w); o.z = pk2(b.x, b.y); o.w = pk2(b.z, b.w);
        ((v4u*)dst)[i] = o;
    }
}
__device__ __forceinline__ void tr_item(const float* W, int ldw, int nvalid, int K, bf16* WT, LAS float* scr, int kb, int n_src0, int n_dst0, int lane) {
    const int k0 = 64 * kb;
#pragma unroll 8
    for (int i = 0; i < 32; ++i) { const int kk = 2 * i + (lane >> 5); const int n = n_src0 + (lane & 31);
        scr[kk * 33 + (lane & 31)] = (n < nvalid) ? W[(size_t)(k0 + kk) * ldw + n] : 0.f; }
    LDS_WAIT(); asm volatile("" ::: "memory");
    const int c = lane & 7;
#pragma unroll
    for (int j = 0; j < 4; ++j) { const int n = (lane >> 3) + 8 * j; const LAS float* s = scr + (8 * c) * 33 + n;
        v4u o; o.x = pk2(s[0 * 33], s[1 * 33]); o.y = pk2(s[2 * 33], s[3 * 33]); o.z = pk2(s[4 * 33], s[5 * 33]); o.w = pk2(s[6 * 33], s[7 * 33]);
        *(v4u*)(WT + (size_t)(n_dst0 + n) * K + k0 + 8 * c) = o; }
    LDS_WAIT(); asm volatile("" ::: "memory");
}
__device__ __forceinline__ void p0_transposes(const Ctx& X, const float* w_in, const float* WF, const float* w_out, const float* w_query, bf16* WIN, bf16* WOUT, bf16* WQ) {
    LAS float* scr = (LAS float*)(X.lds + X.wave * 16384);
    const int gw = X.bid * NWAVES + X.wave, NGW = X.G * NWAVES;
    constexpr int I_IN = 16 * 104, I_OUT = 24 * 32, I_Q = 16 * 64, I_L = I_IN + I_OUT + I_Q;
    for (int it = gw; it < 2 * I_L; it += NGW) {
        const int l = it / I_L; int r = it % I_L;
        if (r < I_IN) { const int kb = r / 104, nb = r % 104;
            if (nb < 16) tr_item(WF + (size_t)l * 1024 * 512, 512, 512, 1024, WIN + (size_t)l * NPROJ_PAD * 1024, scr, kb, nb * 32, nb * 32, X.lane);
            else tr_item(w_in + (size_t)l * 1024 * NPROJ, NPROJ, NPROJ, 1024, WIN + (size_t)l * NPROJ_PAD * 1024, scr, kb, nb * 32, nb * 32, X.lane);
            continue; }
        r -= I_IN;
        if (r < I_OUT) { const int kb = r / 32, nb = r % 32; tr_item(w_out + (size_t)l * NMIX * 1024, 1024, 1024, NMIX, WOUT + (size_t)l * 1024 * NMIX, scr, kb, nb * 32, nb * 32, X.lane); continue; }
        r -= I_OUT;
        { const int kb = r / 64, nb = r % 64; tr_item(w_query + (size_t)l * 1024 * NQ, NQ, NQ, 1024, WQ + (size_t)l * NQ * 1024, scr, kb, nb * 32, nb * 32, X.lane); }
    }
}
__device__ __forceinline__ void norm_mod_phase(const Ctx& X, const float* xin, const float* g, const float* shift, const float* scale, bf16* XN) {
    const int gw = X.bid * NWAVES + X.wave, NGW = X.G * NWAVES;
    for (int m0 = gw * 2; m0 < M; m0 += NGW * 2) {
        f32x4 v[2][4]; float s[2] = {0.f, 0.f};
#pragma unroll
        for (int e = 0; e < 2; ++e) { const f32x4* xr = (const f32x4*)(xin + (size_t)(m0 + e) * DM) + X.lane;
#pragma unroll
            for (int j = 0; j < 4; ++j) v[e][j] = xr[64 * j]; }
        const int b = m0 >> 12;
        f32x4 gv[4], sc[4], sh[4];
#pragma unroll
        for (int j = 0; j < 4; ++j) { const int col = 256 * j + 4 * X.lane; gv[j] = *(const f32x4*)(g + col); sc[j] = *(const f32x4*)(scale + (size_t)b * 6144 + col); sh[j] = *(const f32x4*)(shift + (size_t)b * 6144 + col); }
#pragma unroll
        for (int e = 0; e < 2; ++e)
#pragma unroll
            for (int j = 0; j < 4; ++j) s[e] += (v[e][j].x * v[e][j].x + v[e][j].y * v[e][j].y) + (v[e][j].z * v[e][j].z + v[e][j].w * v[e][j].w);
#pragma unroll
        for (int e = 0; e < 2; ++e) {
            const float rstd = 1.0f / sqrtf(wave_sum(s[e]) * (1.f / DM) + EPS);
            unsigned long long* o8 = (unsigned long long*)(XN + (size_t)(m0 + e) * DM) + X.lane;
#pragma unroll
            for (int j = 0; j < 4; ++j) { const f32x4 o = (v[e][j] * rstd) * gv[j] * (sc[j] + 1.0f) + sh[j];
                o8[64 * j] = (unsigned long long)pk2(o.x, o.y) | ((unsigned long long)pk2(o.z, o.w) << 32); }
        }
    }
}
typedef float f32x4m __attribute__((ext_vector_type(4)));
__device__ __forceinline__ void dt_proj_phase(const Ctx& X, const bf16* XN, const bf16* WT, float* DTRAW) {
    const int gw = X.bid * NWAVES + X.wave, NGW = X.G * NWAVES, rr = X.lane & 15, kg = X.lane >> 4;
    for (int tile = gw; tile < M / 16; tile += NGW) {
        const bf16* arow = XN + (size_t)(tile * 16 + rr) * DM + 8 * kg; const bf16* brow = WT + (size_t)(3072 + rr) * DM + 8 * kg;
        f32x4m acc = {0.f, 0.f, 0.f, 0.f};
#pragma unroll 8
        for (int ks = 0; ks < 32; ++ks) acc = __builtin_amdgcn_mfma_f32_16x16x32_bf16(*(const bf16x8*)(arow + 32 * ks), *(const bf16x8*)(brow + 32 * ks), acc, 0, 0, 0);
#pragma unroll
        for (int i = 0; i < 4; ++i) DTRAW[(size_t)(tile * 16 + 4 * kg + i) * 16 + rr] = acc[i];
    }
}
__device__ __forceinline__ void ssd_a_phase(const Ctx& X, unsigned char* ws, const float* conv_w, const float* conv_b, const float* dt_bias, const float* a_log) {
#define PROJ ((const bf16*)(ws + WS_PROJ))
#define DTRAW ((const float*)(ws + WS_DTRAW))
#define CBC ((bf16*)(ws + WS_CBC))
#define XBT ((bf16*)(ws + WS_XBT))
#define DTV ((float*)(ws + WS_DTV))
#define ACS ((float*)(ws + WS_ACS))
#define CD ((float*)(ws + WS_CD))
#define ST ((bf16*)(ws + WS_ST))
    LAS unsigned char* raw = X.lds;
    LAS unsigned char* BT = X.lds + 67648;
    LAS unsigned char* XTL = X.lds + 102464;
    LAS float* dts = (LAS float*)(X.lds + 119872); LAS float* acsL = dts + 1024; LAS float* wl = dts + 2048;
    LAS float* CW = (LAS float*)(X.lds + 132224);
    const int r_ = X.lane & 31, h = X.lane >> 5;
    for (int u = X.bid; u < NBC * 2; u += X.G) {
        const int bc = u >> 1, g = u & 1, c = bc & 31, t0 = bc * 128;
        {
            v4u rv[9];
#pragma unroll
            for (int k = 0; k < 9; ++k) { const int i = X.tid + k * NT; const int r = (i >> 5) < 131 ? (i >> 5) : 130, ck = i & 31; const int pos = c * 128 + r - 3;
                const int tr = pos >= 0 ? t0 + r - 3 : t0; const int col = (ck < 16 ? 2560 + g * 128 : 2816 + g * 128 - 128) + ck * 8;
                rv[k] = *(const v4u*)(PROJ + (size_t)tr * PROJ_LD + col); if (pos < 0) rv[k] = (v4u){0u, 0u, 0u, 0u}; }
#pragma unroll
            for (int k = 0; k < 9; ++k) { const int i = X.tid + k * NT; const int r = i >> 5, ck = i & 31;
                if (r < 131) { LAS unsigned* d = (LAS unsigned*)(raw + r * 516 + ck * 16); d[0] = rv[k].x; d[1] = rv[k].y; d[2] = rv[k].z; d[3] = rv[k].w; } }
        }
        for (int i = X.tid; i < 3840; i += NT) { const int j = i / 768, cl = i % 768; const int chx = cl < 512 ? g * 512 + cl : (cl < 640 ? 1024 + g * 128 + cl - 512 : 1280 + g * 128 + cl - 640);
            CW[i] = j < 4 ? conv_w[j * 1536 + chx] : conv_b[chx]; }
#pragma unroll
        for (int k = 0; k < 2; ++k) { const int i = X.tid + k * NT, r = i >> 7, l = i & 127, hh = g * 8 + r;
            const float x = DTRAW[(size_t)(t0 + l) * 16 + hh] + dt_bias[hh]; const float ex = __expf(x);
            const float dt = x > 20.f ? x : (ex < 0.015625f ? ex * (1.f - ex * (0.5f - ex * 0.33333333f)) : __logf(1.f + ex));
            dts[i] = dt; wl[i] = -dt * __expf(a_log[hh]); }
        __syncthreads();
        {
            const int cp = X.tid & 127, lr = X.tid >> 7, ch = 2 * cp, cl = 512 + ch;
            float w0[4], w1[4];
#pragma unroll
            for (int j = 0; j < 4; ++j) { w0[j] = CW[j * 768 + cl]; w1[j] = CW[j * 768 + cl + 1]; }
            const float b0 = CW[4 * 768 + cl], b1 = CW[4 * 768 + cl + 1];
            bf16* dst = CBC + (size_t)t0 * 512 + (ch < 128 ? g * 128 + ch : 256 + g * 128 + ch - 128);
            for (int l = 32 * lr; l < 32 * lr + 32; ++l) { float a0 = b0, a1 = b1;
#pragma unroll
                for (int j = 0; j < 4; ++j) { const unsigned w = *(LAS unsigned*)(raw + (l + j) * 516 + cp * 4); a0 += w0[j] * bflo(w); a1 += w1[j] * bfhi(w); }
                *(unsigned*)(dst + (size_t)l * 512) = pk2(siluf(a0), siluf(a1)); }
        }
        {
            const int l = X.tid & 127, cr = X.tid >> 7;
            for (int ci = 0; ci < 32; ++ci) { const int ch = cr * 32 + ci, cl = 512 + ch;
                float a = CW[4 * 768 + cl];
#pragma unroll
                for (int j = 0; j < 4; ++j) a += CW[j * 768 + cl] * bf2f(*(LAS unsigned short*)(raw + (l + j) * 516 + ch * 2));
                *(LAS unsigned short*)(BT + ch * 272 + l * 2) = (unsigned short)f2bf(siluf(a)); }
        }
        {
#pragma unroll
            for (int k = 0; k < 2; ++k) { const int i = X.tid + k * NT; float v = wl[i];
#pragma unroll
                for (int o = 1; o < 64; o <<= 1) { const float up = __shfl_up(v, o); if (X.lane >= o) v += up; }
                acsL[i] = v; }
        }
        __syncthreads();
#pragma unroll
        for (int k = 0; k < 2; ++k) { const int i = X.tid + k * NT; if (i & 64) acsL[i] += acsL[(i & ~127) + 63]; }
        __syncthreads();
#pragma unroll
        for (int k = 0; k < 2; ++k) { const int i = X.tid + k * NT, r = i >> 7, l = i & 127, hh = g * 8 + r; const float tot = acsL[(i & ~127) + 127], a = acsL[i];
            wl[i] = __expf(tot - a) * dts[i];
            DTV[(size_t)(bc * 16 + hh) * 128 + l] = dts[i]; ACS[(size_t)(bc * 16 + hh) * 128 + l] = a; if (l == 0) CD[bc * 16 + hh] = __expf(tot); }
        v4u xv[3];
#define SA_XLOAD(hh_) { _Pragma("unroll") for (int k = 0; k < 3; ++k) { const int i = X.tid + k * NT; const int r = (i >> 3) < 131 ? (i >> 3) : 130, ck = i & 7; const int pos = c * 128 + r - 3; \
            const int tr = pos >= 0 ? t0 + r - 3 : t0; xv[k] = *(const v4u*)(PROJ + (size_t)tr * PROJ_LD + 1536 + (hh_) * 64 + ck * 8); if (pos < 0) xv[k] = (v4u){0u, 0u, 0u, 0u}; } }
        SA_XLOAD(g * 8)
        __syncthreads();
#pragma unroll 1
        for (int r = 0; r < 8; ++r) {
            const int hh = g * 8 + r;
#pragma unroll
            for (int k = 0; k < 3; ++k) { const int i = X.tid + k * NT; const int rr = i >> 3, ck = i & 7;
                if (rr < 131) { LAS unsigned* d = (LAS unsigned*)(raw + rr * 132 + ck * 16); d[0] = xv[k].x; d[1] = xv[k].y; d[2] = xv[k].z; d[3] = xv[k].w; } }
            LDS_BARRIER();
            if (r < 7) SA_XLOAD(hh + 1)
            {
                const int l = X.tid & 127, cq = X.tid >> 7;
                for (int ci = 0; ci < 16; ++ci) { const int p = cq * 16 + ci, chx = hh * 64 + p, cl = r * 64 + p;
                    float a = CW[4 * 768 + cl];
#pragma unroll
                    for (int j = 0; j < 4; ++j) a += CW[j * 768 + cl] * bf2f(*(LAS unsigned short*)(raw + (l + j) * 132 + p * 2));
                    const unsigned short o = (unsigned short)f2bf(siluf(a));
                    *(LAS unsigned short*)(XTL + p * 272 + l * 2) = o; XBT[((size_t)bc * 1024 + chx) * 128 + l] = o; }
            }
            LDS_BARRIER();
            {
                const int pb = X.wave & 1, nb = X.wave >> 1;
                const LAS unsigned char* xrow = XTL + (32 * pb + r_) * 272; const LAS unsigned char* brow = BT + (32 * nb + r_) * 272; const LAS float* wr = wl + r * 128;
                f32x16 acc;
#pragma unroll
                for (int i = 0; i < 16; ++i) acc[i] = 0.f;
#pragma unroll
                for (int ks = 0; ks < 8; ++ks) { const int k0 = 16 * ks + 8 * h;
                    const v4u xa = *(const LAS v4u*)(xrow + k0 * 2); const bf16x8 bb = *(const LAS bf16x8*)(brow + k0 * 2);
                    v4u sa; sa.x = pk2(bflo(xa.x) * wr[k0 + 0], bfhi(xa.x) * wr[k0 + 1]); sa.y = pk2(bflo(xa.y) * wr[k0 + 2], bfhi(xa.y) * wr[k0 + 3]);
                    sa.z = pk2(bflo(xa.z) * wr[k0 + 4], bfhi(xa.z) * wr[k0 + 5]); sa.w = pk2(bflo(xa.w) * wr[k0 + 6], bfhi(xa.w) * wr[k0 + 7]);
                    acc = MFMA32(__builtin_bit_cast(bf16x8, sa), bb, acc); }
                bf16* so = ST + ((size_t)(bc * 16 + hh) * 64) * 128;
#pragma unroll
                for (int i = 0; i < 16; ++i) { const int p = 32 * pb + rowoff(i, h); so[(size_t)p * 128 + 32 * nb + r_] = (bf16)f2bf(acc[i]); }
            }
            LDS_BARRIER();
        }
#undef SA_XLOAD
    }
#undef PROJ
#undef DTRAW
#undef CBC
#undef XBT
#undef DTV
#undef ACS
#undef CD
#undef ST
}
__device__ __forceinline__ void ssd_scan_phase(const Ctx& X, bf16* ST, const float* CD, bf16* DST) {
    const int gt = X.bid * NT + X.tid, GT = X.G * NT;
    for (int e = gt; e < 131072; e += GT) {
        const int n4 = e & 31, p = (e >> 5) & 63, hh = (e >> 11) & 15, b = e >> 15;
        bf16* base = ST + ((size_t)((b * 32) * 16 + hh) * 64 + p) * 128 + n4 * 4;
        v2u st[32];
#pragma unroll
        for (int c = 0; c < 32; ++c) st[c] = *(const v2u*)(base + (size_t)c * 131072);
        float h0 = 0.f, h1 = 0.f, h2 = 0.f, h3 = 0.f;
#pragma unroll
        for (int c = 0; c < 32; ++c) { const float cd = CD[(b * 32 + c) * 16 + hh];
            v2u o; o.x = pk2(h0, h1); o.y = pk2(h2, h3); *(v2u*)(DST + (base - ST) + (size_t)c * 131072) = o;
            h0 = h0 * cd + bflo(st[c].x); h1 = h1 * cd + bfhi(st[c].x); h2 = h2 * cd + bflo(st[c].y); h3 = h3 * cd + bfhi(st[c].y); }
    }
}
__device__ __forceinline__ void ssd_c_phase(const Ctx& X, unsigned char* ws, const float* d_skip) {
#define PROJ ((const bf16*)(ws + WS_PROJ))
#define CBC ((const bf16*)(ws + WS_CBC))
#define XBT ((const bf16*)(ws + WS_XBT))
#define DTV ((const float*)(ws + WS_DTV))
#define ACS ((const float*)(ws + WS_ACS))
#define ST ((const bf16*)(ws + WS_ST))
#define YA ((bf16*)(ws + WS_XN))
#define SSQ ((float*)(ws + WS_SSQ))
    LAS unsigned char* CT = X.lds;
    LAS unsigned char* BK = X.lds + 34816;
    LAS unsigned char* XTL = BK; LAS unsigned char* HPL = BK + 17408;
    LAS unsigned char* ML = X.lds + 69632;
    LAS float* acsL = (LAS float*)(X.lds + 104448); LAS float* dtL = acsL + 1024; LAS float* eaL = acsL + 2048; LAS float* ssqL = acsL + 3072;
    const int r_ = X.lane & 31, h = X.lane >> 5;
    for (int u = X.bid; u < NBC * 2; u += X.G) {
        const int bc = u >> 1, g = u & 1, t0 = bc * 128;
        {
            v4u cv[4], bv[4];
#pragma unroll
            for (int k = 0; k < 4; ++k) { const int i = X.tid + k * NT, row = i >> 4, ck = i & 15;
                cv[k] = *(const v4u*)(CBC + (size_t)(t0 + row) * 512 + 256 + g * 128 + ck * 8); bv[k] = *(const v4u*)(CBC + (size_t)(t0 + row) * 512 + g * 128 + ck * 8); }
            float av[2], dv[2];
#pragma unroll
            for (int k = 0; k < 2; ++k) { const int i = X.tid + k * NT; av[k] = ACS[(size_t)(bc * 16 + g * 8) * 128 + i]; dv[k] = DTV[(size_t)(bc * 16 + g * 8) * 128 + i]; }
#pragma unroll
            for (int k = 0; k < 4; ++k) { const int i = X.tid + k * NT, row = i >> 4, ck = i & 15; *(LAS v4u*)(CT + row * 272 + ck * 16) = cv[k]; *(LAS v4u*)(BK + row * 272 + ck * 16) = bv[k]; }
#pragma unroll
            for (int k = 0; k < 2; ++k) { const int i = X.tid + k * NT; acsL[i] = av[k]; dtL[i] = dv[k]; eaL[i] = __expf(av[k]); }
        }
        v4u xr[2], hr[2];
#define SC_XHLOAD(hh_) { _Pragma("unroll") for (int k = 0; k < 2; ++k) { const int i = X.tid + k * NT; \
            xr[k] = *(const v4u*)(XBT + ((size_t)bc * 1024 + (hh_) * 64) * 128 + (size_t)i * 8); hr[k] = *(const v4u*)(ST + ((size_t)(bc * 16 + (hh_)) * 64) * 128 + (size_t)i * 8); } }
        SC_XHLOAD(g * 8)
        __syncthreads();
        f32x16 cb[2];
        const int lb = X.wave >> 1, sh = X.wave & 1;
#pragma unroll
        for (int j = 0; j < 2; ++j) { const int sb = 2 * sh + j;
#pragma unroll
            for (int i = 0; i < 16; ++i) cb[j][i] = 0.f;
            if (sb <= lb) {
                const LAS unsigned char* crow = CT + (32 * lb + r_) * 272; const LAS unsigned char* brow = BK + (32 * sb + r_) * 272;
#pragma unroll
                for (int ks = 0; ks < 8; ++ks) { const int k0 = 16 * ks + 8 * h; cb[j] = MFMA32(*(const LAS bf16x8*)(crow + k0 * 2), *(const LAS bf16x8*)(brow + k0 * 2), cb[j]); }
            }
        }
        __syncthreads();
#pragma unroll 1
        for (int r = 0; r < 8; ++r) {
            const int hh = g * 8 + r; const LAS float* ac = acsL + r * 128; const LAS float* dl = dtL + r * 128; const LAS float* ea = eaL + r * 128;
#pragma unroll
            for (int k = 0; k < 2; ++k) { const int i = X.tid + k * NT, row = i >> 4, ck = i & 15; *(LAS v4u*)(XTL + row * 272 + ck * 16) = xr[k]; *(LAS v4u*)(HPL + row * 272 + ck * 16) = hr[k]; }
#pragma unroll
            for (int j = 0; j < 2; ++j) { const int sb = 2 * sh + j;
                if (sb <= lb) { const int s_ = 32 * sb + r_; const float as = ac[s_], ds = dl[s_];
#pragma unroll
                    for (int i = 0; i < 16; ++i) { const int l = 32 * lb + rowoff(i, h); const float vv = cb[j][i] * __expf(ac[l] - as) * ds; const unsigned msk = (unsigned)((l - s_) >> 31);
                        *(LAS unsigned short*)(ML + l * 272 + s_ * 2) = (unsigned short)f2bf(__uint_as_float(__float_as_uint(vv) & ~msk));
                        if ((i & 3) == 3) __builtin_amdgcn_sched_barrier(0); } }
            }
            LDS_BARRIER();
            if (r < 7) SC_XHLOAD(hh + 1)
            {
                const int lb2 = X.wave >> 1, pb = X.wave & 1, p = 32 * pb + r_;
                unsigned short zv[16];
                const char* zb = (const char*)PROJ + ((size_t)(t0 + 32 * lb2) * PROJ_LD + 512 + hh * 64) * 2; const unsigned zo = (unsigned)(4 * h * PROJ_LD + p) * 2u;
#pragma unroll
                for (int i = 0; i < 16; ++i) zv[i] = *(const unsigned short*)(zb + (size_t)((i & 3) + 8 * (i >> 2)) * PROJ_LD * 2 + zo);
                f32x16 accd, acco;
#pragma unroll
                for (int i = 0; i < 16; ++i) { accd[i] = 0.f; acco[i] = 0.f; }
                const LAS unsigned char* mrow = ML + (32 * lb2 + r_) * 272; const LAS unsigned char* xrow = XTL + p * 272;
                for (int ks = 0; ks < 2 * (lb2 + 1); ++ks) { const int k0 = 16 * ks + 8 * h; accd = MFMA32(*(const LAS bf16x8*)(mrow + k0 * 2), *(const LAS bf16x8*)(xrow + k0 * 2), accd); }
                const LAS unsigned char* crow = CT + (32 * lb2 + r_) * 272; const LAS unsigned char* hrow = HPL + p * 272;
#pragma unroll 4
                for (int ks = 0; ks < 8; ++ks) { const int k0 = 16 * ks + 8 * h; acco = MFMA32(*(const LAS bf16x8*)(crow + k0 * 2), *(const LAS bf16x8*)(hrow + k0 * 2), acco); }
                const float dsk = d_skip[hh];
                char* yb = (char*)YA + ((size_t)(t0 + 32 * lb2) * NMIX + 512 + hh * 64) * 2; const unsigned yo = (unsigned)(4 * h * NMIX + p) * 2u;
#pragma unroll
                for (int i = 0; i < 16; ++i) { const int l = 32 * lb2 + rowoff(i, h);
                    float y = accd[i] + ea[l] * acco[i];
                    y += dsk * bf2f(*(const LAS unsigned short*)(xrow + l * 2));
                    const float yg = y * siluf(bf2f(zv[i]));
                    *(unsigned short*)(yb + (size_t)((i & 3) + 8 * (i >> 2)) * NMIX * 2 + yo) = (unsigned short)f2bf(yg);
                    float q = yg * yg;
                    q = DPP_ADD(q, 0xB1); q = DPP_ADD(q, 0x4E); q = DPP_ADD(q, 0x141); q = DPP_ADD(q, 0x140); q += __shfl_xor(q, 16);
                    if (r_ == 0) ssqL[l * 2 + pb] = q;
                    if ((i & 3) == 3) __builtin_amdgcn_sched_barrier(0); }
            }
            LDS_BARRIER();
            if (X.tid < 128) SSQ[(size_t)(t0 + X.tid) * 16 + hh] = ssqL[X.tid * 2] + ssqL[X.tid * 2 + 1];
            LDS_BARRIER();
        }
#undef SC_XHLOAD
    }
#undef PROJ
#undef CBC
#undef XBT
#undef DTV
#undef ACS
#undef ST
#undef YA
#undef SSQ
}
__device__ __forceinline__ void mix_finish_phase(const Ctx& X, const bf16* PROJ, const float* SSQ, const float* ssd_norm, const float* pool_b, const float* pool_scale, bf16* YA) {
    for (int rb = X.bid; rb < M / 64; rb += X.G) {
        const int t0 = rb * 64 + X.wave * 8, pos0 = t0 & 4095;
        {
            v4u ya[8][2]; float q[8];
#pragma unroll
            for (int i = 0; i < 8; ++i) { const bf16* yp = YA + (size_t)(t0 + i) * NMIX + 512 + 8 * X.lane; ya[i][0] = *(const v4u*)yp; ya[i][1] = *(const v4u*)(yp + 512);
                q[i] = (X.lane < 16) ? SSQ[(size_t)(t0 + i) * 16 + X.lane] : 0.f; }
            f32x4 gn[2][2];
#pragma unroll
            for (int hf = 0; hf < 2; ++hf) { gn[hf][0] = *(const f32x4*)(ssd_norm + hf * 512 + 8 * X.lane); gn[hf][1] = *(const f32x4*)(ssd_norm + hf * 512 + 8 * X.lane + 4); }
#pragma unroll
            for (int i = 0; i < 8; ++i) { const float rstd = 1.0f / sqrtf(wave_sum(q[i]) * (1.f / 1024.f) + EPS);
#pragma unroll
                for (int hf = 0; hf < 2; ++hf) { const v4u v = ya[i][hf]; const f32x4 g0 = gn[hf][0], g1 = gn[hf][1];
                    v4u o; o.x = pk2(bflo(v.x) * rstd * g0.x, bfhi(v.x) * rstd * g0.y); o.y = pk2(bflo(v.y) * rstd * g0.z, bfhi(v.y) * rstd * g0.w);
                    o.z = pk2(bflo(v.z) * rstd * g1.x, bfhi(v.z) * rstd * g1.y); o.w = pk2(bflo(v.w) * rstd * g1.z, bfhi(v.w) * rstd * g1.w);
                    *(v4u*)(YA + (size_t)(t0 + i) * NMIX + 512 + hf * 512 + 8 * X.lane) = o; } }
        }
#pragma unroll 1
        for (int hb = 0; hb < 2; ++hb) {
            const int tb = t0 + 4 * hb, pb0 = pos0 + 4 * hb;
            const int ch = 8 * X.lane, w = 2 << (X.lane >> 4);
            v4u u[19];
#pragma unroll
            for (int k = 0; k < 19; ++k) { const bool ok = pb0 - 15 + k >= 0; const int tr = ok ? tb - 15 + k : tb; u[k] = *(const v4u*)(PROJ + (size_t)tr * PROJ_LD + ch); if (!ok) u[k] = (v4u){0u, 0u, 0u, 0u}; }
            float mk[16];
#pragma unroll
            for (int j = 0; j < 16; ++j) mk[j] = (j < w) ? 1.f : 0.f;
            float S[4][8];
#pragma unroll
            for (int i = 0; i < 4; ++i)
#pragma unroll
                for (int e = 0; e < 8; ++e) S[i][e] = 0.f;
#pragma unroll
            for (int k = 0; k < 19; ++k) { const float f[8] = {bflo(u[k].x), bfhi(u[k].x), bflo(u[k].y), bfhi(u[k].y), bflo(u[k].z), bfhi(u[k].z), bflo(u[k].w), bfhi(u[k].w)};
#pragma unroll
                for (int i = 0; i < 4; ++i) { const int j = 15 + i - k; if (j >= 0 && j < 16) {
#pragma unroll
                    for (int e = 0; e < 8; ++e) S[i][e] += mk[j] * f[e]; } } }
            const f32x4 b0 = *(const f32x4*)(pool_b + ch), b1 = *(const f32x4*)(pool_b + ch + 4), c0 = *(const f32x4*)(pool_scale + ch), c1 = *(const f32x4*)(pool_scale + ch + 4);
            const float bb[8] = {b0.x, b0.y, b0.z, b0.w, b1.x, b1.y, b1.z, b1.w}, cc[8] = {c0.x, c0.y, c0.z, c0.w, c1.x, c1.y, c1.z, c1.w};
#pragma unroll
            for (int i = 0; i < 4; ++i) { const int pos = pb0 + i; const float inv = 1.0f / (float)((pos + 1 < w) ? (pos + 1) : w); const v4u cu = u[15 + i];
                const float cur[8] = {bflo(cu.x), bfhi(cu.x), bflo(cu.y), bfhi(cu.y), bflo(cu.z), bfhi(cu.z), bflo(cu.w), bfhi(cu.w)};
                float o[8];
#pragma unroll
                for (int e = 0; e < 8; ++e) o[e] = (S[i][e] * inv - cur[e] + bb[e]) * cc[e];
                v4u ov; ov.x = pk2(o[0], o[1]); ov.y = pk2(o[2], o[3]); ov.z = pk2(o[4], o[5]); ov.w = pk2(o[6], o[7]);
                *(v4u*)(YA + (size_t)(tb + i) * NMIX + ch) = ov; }
        }
    }
}
__device__ __forceinline__ unsigned f2key(float f) { const unsigned b = __float_as_uint(f); return b ^ ((unsigned)((int)b >> 31) | 0x80000000u); }
__device__ __forceinline__ float key2f(unsigned u) { const unsigned b = (u & 0x80000000u) ? (u ^ 0x80000000u) : ~u; return __uint_as_float(b); }
__device__ __forceinline__ void cs_desc(unsigned& a, unsigned& b) { const unsigned hi = a > b ? a : b, lo = a > b ? b : a; a = hi; b = lo; }
__device__ __forceinline__ void bitonic_sort16_desc(unsigned (&a)[16]) {
#pragma unroll
    for (int k = 2; k <= 16; k <<= 1)
#pragma unroll
        for (int j = k >> 1; j > 0; j >>= 1)
#pragma unroll
            for (int i = 0; i < 16; ++i) { const int l = i ^ j; if (l > i) { if ((i & k) == 0) cs_desc(a[i], a[l]); else cs_desc(a[l], a[i]); } }
}
__device__ __forceinline__ void merge_top16_desc(unsigned (&a)[16], const unsigned (&b)[16]) {
#pragma unroll
    for (int i = 0; i < 16; ++i) a[i] = a[i] > b[15 - i] ? a[i] : b[15 - i];
#pragma unroll
    for (int j = 8; j > 0; j >>= 1)
#pragma unroll
        for (int i = 0; i < 16; ++i) { const int l = i ^ j; if (l > i) cs_desc(a[i], a[l]); }
}
#define INSK(L, kk) do { unsigned _v = (kk); _Pragma("unroll") for (int _j = 0; _j < 16; ++_j) { const unsigned _t = L[_j] > _v ? L[_j] : _v; _v = L[_j] > _v ? _v : L[_j]; L[_j] = _t; } } while (0)
__device__ __forceinline__ void route_phase(const Ctx& X, const bf16* Q, const bf16* KEYS_l, int* IDX, float* GATE) {
    LAS bf16* KL = (LAS bf16*)X.lds;
    const int r = X.lane & 31, h = X.lane >> 5;
    for (int u = X.bid; u < (M / 256) * 8; u += X.G) {
        const int tb = u >> 3, hd = u & 7;
        for (int i = X.tid; i < 4096; i += NT) { const int half = i >> 11, row = (i >> 4) & 127, ck = i & 15;
            const v4u v = *(const v4u*)(KEYS_l + ((size_t)(half * 8 + hd) * 128 + row) * 128 + ck * 8);
            *(LAS v4u*)(KL + (half * 128 + row) * 136 + ck * 8) = v; }
        __syncthreads();
        const int tok = tb * 256 + X.wave * 32 + r;
        unsigned K1[16], L[16];
#pragma unroll
        for (int half = 0; half < 2; ++half) {
            f32x16 acc[4];
#pragma unroll
            for (int mt = 0; mt < 4; ++mt)
#pragma unroll
                for (int i = 0; i < 16; ++i) acc[mt][i] = 0.f;
            const bf16* qrow = Q + (size_t)tok * NQ + hd * 256 + half * 128;
#pragma unroll
            for (int ks = 0; ks < 8; ++ks) { const int k0 = 16 * ks + 8 * h; const bf16x8 qb = *(const bf16x8*)(qrow + k0);
#pragma unroll
                for (int mt = 0; mt < 4; ++mt) acc[mt] = MFMA32(*(const LAS bf16x8*)(KL + (half * 128 + 32 * mt + r) * 136 + k0), qb, acc[mt]); }
            {
                unsigned G1[16], G2[16], G3[16];
#pragma unroll
                for (int i = 0; i < 16; ++i) { L[i] = (f2key(acc[0][i]) & ~127u) | (unsigned)(0 + rowoff(i, h)); G1[i] = (f2key(acc[1][i]) & ~127u) | (unsigned)(32 + rowoff(i, h));
                    G2[i] = (f2key(acc[2][i]) & ~127u) | (unsigned)(64 + rowoff(i, h)); G3[i] = (f2key(acc[3][i]) & ~127u) | (unsigned)(96 + rowoff(i, h)); }
                bitonic_sort16_desc(L); bitonic_sort16_desc(G1); bitonic_sort16_desc(G2); bitonic_sort16_desc(G3);
                merge_top16_desc(L, G1); merge_top16_desc(G2, G3); merge_top16_desc(L, G2);
                unsigned S[16];
#pragma unroll
                for (int j = 0; j < 16; ++j) S[j] = (unsigned)__shfl_xor((int)L[j], 32);
                merge_top16_desc(L, S);
            }
            if (half == 0) {
#pragma unroll
                for (int j = 0; j < 16; ++j) K1[j] = L[j];
            }
        }
        float V1[16], V2[16];
#pragma unroll
        for (int j = 0; j < 16; ++j) { V1[j] = key2f(K1[j] & ~127u); V2[j] = key2f(L[j] & ~127u); }
#define CKEY(a, b) ((f2key(V1[a] + V2[b]) & ~255u) | (unsigned)((a) * 16 + (b)))
        unsigned C[16] = {CKEY(0, 0), CKEY(0, 1), CKEY(0, 2), CKEY(0, 3), CKEY(0, 4), CKEY(0, 5), CKEY(0, 6), CKEY(0, 7), CKEY(0, 8), CKEY(0, 9), CKEY(0, 10), CKEY(0, 11), CKEY(0, 12), CKEY(0, 13), CKEY(0, 14), CKEY(0, 15)};
        unsigned D1[16] = {CKEY(1, 0), CKEY(1, 1), CKEY(1, 2), CKEY(1, 3), CKEY(1, 4), CKEY(1, 5), CKEY(1, 6), CKEY(1, 7), CKEY(2, 0), CKEY(2, 1), CKEY(2, 2), CKEY(2, 3), CKEY(2, 4), CKEY(3, 0), CKEY(3, 1), CKEY(3, 2)};
        unsigned D2[16] = {CKEY(3, 3), CKEY(4, 0), CKEY(4, 1), CKEY(4, 2), CKEY(5, 0), CKEY(5, 1), CKEY(6, 0), CKEY(6, 1), CKEY(7, 0), CKEY(7, 1), CKEY(8, 0), CKEY(9, 0), CKEY(10, 0), CKEY(11, 0), CKEY(12, 0), CKEY(13, 0)};
        unsigned D3[16] = {CKEY(14, 0), CKEY(15, 0), 0u, 0u, 0u, 0u, 0u, 0u, 0u, 0u, 0u, 0u, 0u, 0u, 0u, 0u};
#undef CKEY
        bitonic_sort16_desc(C); bitonic_sort16_desc(D1); bitonic_sort16_desc(D2); if (D3[1] > D3[0]) { const unsigned t_ = D3[0]; D3[0] = D3[1]; D3[1] = t_; }
        merge_top16_desc(C, D1); merge_top16_desc(D2, D3); merge_top16_desc(C, D2);
        float e[16], s = 0.f; const float top = key2f(C[0] & ~255u);
#pragma unroll
        for (int j = 0; j < 16; ++j) { e[j] = __expf(key2f(C[j] & ~255u) - top); s += e[j]; }
        const float inv = 1.0f / s;
        int* ip = IDX + (size_t)tok * 128 + hd * 16; float* gp = GATE + (size_t)tok * 128 + hd * 16;
        LAS unsigned char* sc8 = (LAS unsigned char*)(X.lds + 73728) + X.tid * 32;
        { v4u p1, p2;
          p1.x = (K1[0] & 127u) | ((K1[1] & 127u) << 8) | ((K1[2] & 127u) << 16) | ((K1[3] & 127u) << 24); p1.y = (K1[4] & 127u) | ((K1[5] & 127u) << 8) | ((K1[6] & 127u) << 16) | ((K1[7] & 127u) << 24);
          p1.z = (K1[8] & 127u) | ((K1[9] & 127u) << 8) | ((K1[10] & 127u) << 16) | ((K1[11] & 127u) << 24); p1.w = (K1[12] & 127u) | ((K1[13] & 127u) << 8) | ((K1[14] & 127u) << 16) | ((K1[15] & 127u) << 24);
          p2.x = (L[0] & 127u) | ((L[1] & 127u) << 8) | ((L[2] & 127u) << 16) | ((L[3] & 127u) << 24); p2.y = (L[4] & 127u) | ((L[5] & 127u) << 8) | ((L[6] & 127u) << 16) | ((L[7] & 127u) << 24);
          p2.z = (L[8] & 127u) | ((L[9] & 127u) << 8) | ((L[10] & 127u) << 16) | ((L[11] & 127u) << 24); p2.w = (L[12] & 127u) | ((L[13] & 127u) << 8) | ((L[14] & 127u) << 16) | ((L[15] & 127u) << 24);
          *(LAS v4u*)sc8 = p1; *(LAS v4u*)(sc8 + 16) = p2; }
#pragma unroll
        for (int j = 0; j < 16; ++j) {
            const unsigned a = (C[j] >> 4) & 15u, b = C[j] & 15u;
            const unsigned i1 = sc8[a], i2 = sc8[16 + b];
            if (h == (j >> 3)) { ip[j] = (int)(i1 * 128u + i2); gp[j] = e[j] * inv; }
        }
        __syncthreads();
    }
}
__device__ __forceinline__ void peer_sort_phase(const Ctx& X, const int* IDX, const float* GATE, int* ENT, float* GS, unsigned short* OFFT) {
    LAS unsigned char* OL = X.lds;
    for (int tile = X.bid; tile < M / 64; tile += X.G) {
        int pe0[8], pe1[8]; float pg0[8], pg1[8];
#pragma unroll
        for (int i = 0; i < 8; ++i) { const size_t t = (size_t)tile * 64 + X.wave * 8 + i;
            pe0[i] = IDX[t * 128 + X.lane]; pe1[i] = IDX[t * 128 + 64 + X.lane]; pg0[i] = GATE[t * 128 + X.lane]; pg1[i] = GATE[t * 128 + 64 + X.lane]; }
#pragma unroll
        for (int i = 0; i < 8; ++i) {
            const int tl = X.wave * 8 + i, t = tile * 64 + tl;
            const int e0 = pe0[i], e1 = pe1[i]; const float g0 = pg0[i], g1 = pg1[i];
            const unsigned key0 = ((unsigned)(e0 >> 9) << 7) | (unsigned)X.lane, key1 = ((unsigned)(e1 >> 9) << 7) | (unsigned)(64 + X.lane);
            int pos0 = 0, pos1 = 0, cnt = 0;
#pragma unroll 8
            for (int j = 0; j < 64; ++j) {
                const unsigned a = (unsigned)__builtin_amdgcn_readlane((int)key0, j), b = (unsigned)__builtin_amdgcn_readlane((int)key1, j);
                pos0 += (a < key0) + (b < key0); pos1 += (a < key1) + (b < key1);
                cnt += ((a >> 7) < (unsigned)X.lane) + ((b >> 7) < (unsigned)X.lane);
            }
            ENT[(size_t)t * 128 + pos0] = e0; ENT[(size_t)t * 128 + pos1] = e1; GS[(size_t)t * 128 + pos0] = g0; GS[(size_t)t * 128 + pos1] = g1;
            if (X.lane <= 32) OL[tl * 40 + X.lane] = (unsigned char)cnt;
        }
        __syncthreads();
        for (int i = X.tid; i < 2048; i += NT) { const int c = i >> 6, tl = i & 63; const unsigned o0 = OL[tl * 40 + c], o1 = OL[tl * 40 + c + 1];
            OFFT[(size_t)c * M + tile * 64 + tl] = (unsigned short)(o0 | ((o1 - o0) << 8)); }
        __syncthreads();
    }
}
typedef __bf16 bf16x2_t __attribute__((ext_vector_type(2)));
typedef short s16x4_t __attribute__((ext_vector_type(4)));
__device__ __forceinline__ float dot2bf(unsigned a, unsigned b, float c) { return __builtin_amdgcn_fdot2_f32_bf16(__builtin_bit_cast(bf16x2_t, a), __builtin_bit_cast(bf16x2_t, b), c, false); }
__device__ __forceinline__ void down_load_ent(const int* ENT, const bf16* XN, unsigned w, int q, int rot, int s, int base, int (&ent)[4], v4u (&hv)[4]) {
    const int t = (int)(w >> 16), off0 = (int)(w & 0xffu);
    { int p = off0 + base + 4 * q; p = p < 124 ? p : 124; const v4u ev = *(const v4u*)(ENT + (size_t)t * 128 + p); const int sh = off0 + base + 4 * q - p;
      ent[0] = (int)(sh == 0 ? ev.x : (sh == 1 ? ev.y : (sh == 2 ? ev.z : ev.w))); ent[1] = (int)(sh == 0 ? ev.y : (sh == 1 ? ev.z : ev.w)); ent[2] = (int)(sh == 0 ? ev.z : ev.w); ent[3] = (int)ev.w; }
#pragma unroll
    for (int ii = 0; ii < 4; ++ii) hv[ii] = *(const v4u*)(XN + (size_t)t * DM + s * 128 + (4 * ((ii + rot) & 3) + q) * 8);
}
__device__ __forceinline__ void down_compute(LAS unsigned char* DL, float* PART, unsigned w, int s, int q, int rot, int nb, int base, const int (&ent)[4], const v4u (&hv)[4]) {
    const int t = (int)(w >> 16), off0 = (int)(w & 0xffu), n = (int)((w >> 8) & 0xffu);
    float res[4] = {0.f, 0.f, 0.f, 0.f};
    v4u dA[4], dB[4], dC[4], dD[4];
#define DOWN_ROW(i, D) { const int e_ = __builtin_amdgcn_update_dpp(0, ent[(i) & 3], (((i) >> 2) & 3) * 0x55, 0xF, 0xF, true); const LAS unsigned char* rp_ = DL + (e_ & 511) * 256 + q * 16; \
        D[0] = *(const LAS v4u*)(rp_ + ((0 + rot) & 3) * 64); D[1] = *(const LAS v4u*)(rp_ + ((1 + rot) & 3) * 64); D[2] = *(const LAS v4u*)(rp_ + ((2 + rot) & 3) * 64); D[3] = *(const LAS v4u*)(rp_ + ((3 + rot) & 3) * 64); }
#define DOWN_MATH(i, D) { f32x4 ca = {0.f, 0.f, 0.f, 0.f}, cb = {0.f, 0.f, 0.f, 0.f}; \
        _Pragma("unroll") for (int ii = 0; ii < 4; ++ii) { \
            ca = __builtin_amdgcn_mfma_f32_4x4x4bf16_1k(__builtin_bit_cast(s16x4_t, (v2u){D[ii].x, D[ii].y}), __builtin_bit_cast(s16x4_t, (v2u){hv[ii].x, hv[ii].y}), ca, 0, 0, 0); \
            cb = __builtin_amdgcn_mfma_f32_4x4x4bf16_1k(__builtin_bit_cast(s16x4_t, (v2u){D[ii].z, D[ii].w}), __builtin_bit_cast(s16x4_t, (v2u){hv[ii].z, hv[ii].w}), cb, 0, 0, 0); } \
        const f32x4 c4 = ca + cb; float acc = q == 0 ? c4[0] : (q == 1 ? c4[1] : (q == 2 ? c4[2] : c4[3]));     \
        acc = DPP_ADD(acc, 0xB1); acc = DPP_ADD(acc, 0x4E); \
        if (q == (((i) >> 2) & 3)) res[(i) & 3] = acc; }
#define DOWN_STEP2(i, Dc0, Dc1, Dn0, Dn1) { if ((i) >= nb) goto down_done; DOWN_ROW((i) + 2, Dn0) DOWN_ROW((i) + 3, Dn1) __builtin_amdgcn_sched_barrier(0); DOWN_MATH(i, Dc0) DOWN_MATH((i) + 1, Dc1) __builtin_amdgcn_sched_barrier(0); }
    DOWN_ROW(0, dA) DOWN_ROW(1, dB)
    DOWN_STEP2(0, dA, dB, dC, dD) DOWN_STEP2(2, dC, dD, dA, dB) DOWN_STEP2(4, dA, dB, dC, dD) DOWN_STEP2(6, dC, dD, dA, dB)
    DOWN_STEP2(8, dA, dB, dC, dD) DOWN_STEP2(10, dC, dD, dA, dB) DOWN_STEP2(12, dA, dB, dC, dD) DOWN_STEP2(14, dC, dD, dA, dB)
    down_done:;
#undef DOWN_STEP2
#undef DOWN_ROW
#undef DOWN_MATH
#pragma unroll
    for (int r = 0; r < 4; ++r) { const int j = base + 4 * q + r; if (j < n) PART[((size_t)s * M + t) * 128 + off0 + j] = res[r]; }
}
__device__ __forceinline__ int wave_max_i(int v) {
#pragma unroll
    for (int o = 4; o < 64; o <<= 1) { const int u = __shfl_xor(v, o); v = u > v ? u : v; }
    return __builtin_amdgcn_readfirstlane(v);
}
constexpr int LIST_STRIDE = 16384 + 64;
__device__ __forceinline__ void peer_down_phase(const Ctx& X, const float* e_down_l, const bf16* XN, const int* ENT, const unsigned short* OFFT, unsigned* LISTG, float* PART, int ghost) {
    LAS unsigned char* DL = X.lds;
    LAS unsigned* HB = (LAS unsigned*)(X.lds + 132096);
    const int q = X.lane & 3, tg = X.lane >> 2, rot = (tg >> 1) & 3;
    for (int role = X.bid; role < 256; role += X.G) {
        const int s = role & 7, c = role >> 3;
        for (int i = X.tid; i < 1040; i += NT) HB[i] = 0u;
#pragma unroll 1
        for (int i0 = X.tid; i0 < 512 * 32; i0 += NT * 8) {
            f32x4 v[8]; const char* db = (const char*)(e_down_l + (size_t)(c * 512) * DM + s * 128); const unsigned vo = (unsigned)((i0 >> 5) * DM + (i0 & 31) * 4) * 4u;
#pragma unroll
            for (int u = 0; u < 8; ++u) v[u] = *(const f32x4*)(db + (size_t)u * 16 * DM * 4 + vo);
#pragma unroll
            for (int u = 0; u < 8; ++u) { const int i = i0 + u * NT; v2u o; o.x = pk2(v[u].x, v[u].y); o.y = pk2(v[u].z, v[u].w); *(LAS v2u*)(DL + (i >> 5) * 256 + (i & 31) * 8) = o; }
        }
        __syncthreads();
        const unsigned short* oc = OFFT + (size_t)c * M; unsigned* LIST = LISTG + (size_t)role * LIST_STRIDE;
        unsigned wv[32];
#pragma unroll
        for (int u = 0; u < 32; ++u) wv[u] = oc[X.tid + u * NT];
#pragma unroll
        for (int u = 0; u < 32; ++u) { const unsigned n = wv[u] >> 8; if (n) __hip_atomic_fetch_add(HB + (u >> 2) * 64 + (n < 63u ? n : 63u), 1u, __ATOMIC_RELAXED, __HIP_MEMORY_SCOPE_WORKGROUP); }
        __syncthreads();
        if (X.tid == 0) { unsigned acc = 0u; for (int wdw = 0; wdw < 8; ++wdw) for (int n = 63; n >= 1; --n) { HB[512 + wdw * 64 + n] = acc; acc += HB[wdw * 64 + n]; } HB[1024] = acc; }
        __syncthreads();
        const int total = (int)HB[1024];
#pragma unroll
        for (int u = 0; u < 32; ++u) { const unsigned n = wv[u] >> 8; if (n) { const unsigned pos = __hip_atomic_fetch_add(HB + 512 + (u >> 2) * 64 + (n < 63u ? n : 63u), 1u, __ATOMIC_RELAXED, __HIP_MEMORY_SCOPE_WORKGROUP);
            LIST[pos] = ((unsigned)(X.tid + u * NT) << 16) | wv[u]; } }
        if (X.tid < 32) LIST[total + X.tid] = 0u;
        asm volatile("s_waitcnt vmcnt(0)" ::: "memory");
        __syncthreads();
        const int nbatch = ghost == 3 ? 0 : (total + 15) >> 4, lim = total + 15;
#define LWORD(bi_) ({ int ix_ = 16 * (bi_) + tg; ix_ = ix_ < lim ? ix_ : lim; LIST[ix_]; })
        unsigned wA, wB, wC; int entA[4], entB[4]; v4u hvA[4], hvB[4];
        int bi = X.wave;
        wA = LWORD(bi); wB = LWORD(bi + NWAVES); wC = LWORD(bi + 2 * NWAVES);
        down_load_ent(ENT, XN, wA, q, rot, s, 0, entA, hvA);
        down_load_ent(ENT, XN, wB, q, rot, s, 0, entB, hvB);
#pragma unroll 1
        for (; bi < nbatch; bi += NWAVES) {
            unsigned wD; int entC[4]; v4u hvC[4];
            wD = LWORD(bi + 3 * NWAVES);
            down_load_ent(ENT, XN, wC, q, rot, s, 0, entC, hvC);
            if (ghost == 1) { if (wA == 0xffffffffu) PART[wA >> 16] = __uint_as_float(hvA[0].x + hvA[1].y + hvA[2].z + hvA[3].w + entA[0] + entA[1] + entA[2] + entA[3]); }
            else {
                const int nb = wave_max_i((int)((wA >> 8) & 0xffu));
                down_compute(DL, PART, wA, s, q, rot, nb, 0, entA, hvA);
                for (int base = 16; base < nb; base += 16) {
                    int entX[4]; v4u hvX[4]; down_load_ent(ENT, XN, wA, q, rot, s, base, entX, hvX);
                    down_compute(DL, PART, wA, s, q, rot, nb - base, base, entX, hvA);
                }
            }
            wA = wB; wB = wC; wC = wD;
#pragma unroll
            for (int r = 0; r < 4; ++r) { entA[r] = entB[r]; hvA[r] = hvB[r]; entB[r] = entC[r]; hvB[r] = hvC[r]; }
        }
#undef LWORD
        __syncthreads();
    }
}
__device__ __forceinline__ float gelu_erf(float x) { return 0.5f * x * (1.0f + erff(x * 0.70710678118654752f)); }
__device__ __forceinline__ void peer_combine_phase(const Ctx& X, const float* PART, const float* GS, const int* ENT, unsigned* STREAM, const float* e_up_l) {
    LAS unsigned* T = (LAS unsigned*)(X.lds + 131072);
    LAS unsigned char* UL = X.lds;
    const bool prefill = (X.G == 256); const int cg = (X.bid & 7) * 32 + (X.bid >> 3);
    int fb = 0;
    for (int tile = X.bid; tile < M / 64; tile += X.G) {
#pragma unroll 1
        for (int hf = 0; hf < 2; ++hf) {
#pragma unroll 1
            for (int i0 = X.tid; i0 < 4096; i0 += NT * 4) {
                f32x4 fv[8]; const int e0 = X.tid + fb * NT * 8; const bool dofill = prefill && fb < 4;
                if (dofill) { const unsigned vo = (unsigned)(e0 * DM + cg * 4) * 4u;
#pragma unroll
                    for (int u = 0; u < 8; ++u) fv[u] = *(const f32x4*)((const char*)e_up_l + (size_t)u * NT * DM * 4 + vo); }
                float pa[4][8], gs[4]; int en[4];
#pragma unroll
                for (int k = 0; k < 4; ++k) { const size_t idx = (size_t)(tile * 64 + hf * 32) * 128 + i0 + k * NT;
#pragma unroll
                    for (int s = 0; s < 8; ++s) pa[k][s] = PART[(size_t)s * M * 128 + idx];
                    gs[k] = GS[idx]; en[k] = ENT[idx]; }
#pragma unroll
                for (int k = 0; k < 4; ++k) { const int i = i0 + k * NT, tl = i >> 7, pos = i & 127;
                    const float a = ((pa[k][0] + pa[k][1]) + (pa[k][2] + pa[k][3])) + ((pa[k][4] + pa[k][5]) + (pa[k][6] + pa[k][7]));
                    T[pos * 33 + tl] = ((unsigned)en[k] << 16) | f2bf(gs[k] * gelu_erf(a)); }
                if (dofill) {
#pragma unroll
                    for (int u = 0; u < 8; ++u) { v2u o; o.x = pk2(fv[u].x, fv[u].y); o.y = pk2(fv[u].z, fv[u].w); *(LAS v2u*)(UL + (e0 + u * NT) * 8) = o; }
                }
                ++fb;
            }
            __syncthreads();
            for (int i = X.tid; i < 1024; i += NT) { const int p4 = i >> 5, tl = i & 31; v4u o; o.x = T[(4 * p4 + 0) * 33 + tl]; o.y = T[(4 * p4 + 1) * 33 + tl]; o.z = T[(4 * p4 + 2) * 33 + tl]; o.w = T[(4 * p4 + 3) * 33 + tl];
                ((v4u*)STREAM)[(size_t)(tile * 32 + p4) * 64 + hf * 32 + tl] = o; }
            __syncthreads();
        }
    }
}
typedef _Float16 h2_t __attribute__((ext_vector_type(2)));
__device__ __forceinline__ unsigned pkh2(float a, float b) { h2_t h; h.x = (_Float16)a; h.y = (_Float16)b; return __builtin_bit_cast(unsigned, h); }
#define UP_ADDR(w) (ghost == 1 ? (unsigned)(X.lane * 8) : (((w) >> 13) & 0x7fff8u))
#define UP_MATH(w, u) { const unsigned clo = (w) & 0xffffu, chi = (w) << 16; \
        a0 = dot2bf((u).x, clo, a0); a1 = dot2bf((u).x, chi, a1); a2 = dot2bf((u).y, clo, a2); a3 = dot2bf((u).y, chi, a3); }
#define UP_BLOCK(wv) { v2u ur_[32]; \
        _Pragma("unroll") for (int u_ = 0; u_ < 8; ++u_) { ur_[4 * u_ + 0] = *(const LAS v2u*)(UL + UP_ADDR(wv[u_].x)); ur_[4 * u_ + 1] = *(const LAS v2u*)(UL + UP_ADDR(wv[u_].y)); \
            ur_[4 * u_ + 2] = *(const LAS v2u*)(UL + UP_ADDR(wv[u_].z)); ur_[4 * u_ + 3] = *(const LAS v2u*)(UL + UP_ADDR(wv[u_].w)); } \
        __builtin_amdgcn_sched_barrier(0); \
        _Pragma("unroll") for (int u_ = 0; u_ < 8; ++u_) { UP_MATH(wv[u_].x, ur_[4 * u_ + 0]) UP_MATH(wv[u_].y, ur_[4 * u_ + 1]) UP_MATH(wv[u_].z, ur_[4 * u_ + 2]) UP_MATH(wv[u_].w, ur_[4 * u_ + 3]) } \
        __builtin_amdgcn_sched_barrier(0); }
#define UP_LOAD(wv, g_) { const int g2_ = ghost == 2 ? 0 : ((g_) < 128 ? (g_) : 127); const unsigned vo_ = (unsigned)((((X.wave + NWAVES * (g2_ >> 2) + trot) & 255) * 32 + (g2_ & 3) * 8) * 64 + X.lane) * 16u; \
        _Pragma("unroll") for (int u_ = 0; u_ < 8; ++u_) wv[u_] = *(const v4u*)(sbase + vo_ + u_ * 1024); }
#define UP_FINISH(g_) { if (((g_) & 3) == 3) { const int t = ((X.wave + NWAVES * ((g_) >> 2) + trot) & 255) * 64 + X.lane, b = t >> 12; \
        const f32x4 xv = *(const f32x4*)(x1 + (size_t)t * DM + cg * 4), gv = *(const f32x4*)(gate_f + (size_t)b * 6144 + cg * 4); \
        f32x4 o; o.x = xv.x + gv.x * a0; o.y = xv.y + gv.y * a1; o.z = xv.z + gv.z * a2; o.w = xv.w + gv.w * a3; \
        *(f32x4*)(x2 + (size_t)t * DM + cg * 4) = o; a0 = 0.f; a1 = 0.f; a2 = 0.f; a3 = 0.f; } }
__device__ __forceinline__ void peer_up_phase(const Ctx& X, const float* e_up_l, const unsigned* STREAM, const float* x1, const float* gate_f, float* x2, int ghost) {
    LAS unsigned char* UL = X.lds;
    const char* sbase = (const char*)STREAM;
    for (int role = X.bid; role < 256; role += X.G) {
        const int cg = (role & 7) * 32 + (role >> 3), trot = (role >> 3);
        if (X.G != 256)
#pragma unroll 1
        for (int e0 = X.tid; e0 < 16384; e0 += NT * 8) {
            f32x4 v[8]; const unsigned vo = (unsigned)(e0 * DM + cg * 4) * 4u;
#pragma unroll
            for (int u = 0; u < 8; ++u) v[u] = *(const f32x4*)((const char*)e_up_l + (size_t)u * NT * DM * 4 + vo);
#pragma unroll
            for (int u = 0; u < 8; ++u) { v2u o; o.x = pk2(v[u].x, v[u].y); o.y = pk2(v[u].z, v[u].w); *(LAS v2u*)(UL + (e0 + u * NT) * 8) = o; }
        }
        __syncthreads();
        float a0 = 0.f, a1 = 0.f, a2 = 0.f, a3 = 0.f;
        v4u wa[8], wb[8];
        UP_LOAD(wa, 0)
#pragma unroll 1
        for (int g = 0; g < 128; g += 2) {
            UP_LOAD(wb, g + 1)
            UP_BLOCK(wa) UP_FINISH(g)
            UP_LOAD(wa, g + 2)
            UP_BLOCK(wb) UP_FINISH(g + 1)
        }
        __syncthreads();
    }
}
#undef UP_ADDR
#undef UP_MATH
#undef UP_BLOCK
#undef UP_LOAD
#undef UP_FINISH
__device__ __forceinline__ void final_norm_phase(const Ctx& X, const float* xin, const float* g, float* out) {
    const int gw = X.bid * NWAVES + X.wave, NGW = X.G * NWAVES;
    for (int m0 = gw * 2; m0 < M; m0 += NGW * 2) {
        f32x4 v[2][4]; float s[2] = {0.f, 0.f};
#pragma unroll
        for (int e = 0; e < 2; ++e) { const f32x4* xr = (const f32x4*)(xin + (size_t)(m0 + e) * DM) + X.lane;
#pragma unroll
            for (int j = 0; j < 4; ++j) v[e][j] = xr[64 * j]; }
        f32x4 gv[4];
#pragma unroll
        for (int j = 0; j < 4; ++j) gv[j] = *(const f32x4*)(g + 256 * j + 4 * X.lane);
#pragma unroll
        for (int e = 0; e < 2; ++e)
#pragma unroll
            for (int j = 0; j < 4; ++j) s[e] += (v[e][j].x * v[e][j].x + v[e][j].y * v[e][j].y) + (v[e][j].z * v[e][j].z + v[e][j].w * v[e][j].w);
#pragma unroll
        for (int e = 0; e < 2; ++e) { const float rstd = 1.0f / sqrtf(wave_sum(s[e]) * (1.f / DM) + EPS);
            f32x4* o = (f32x4*)(out + (size_t)(m0 + e) * DM) + X.lane;
#pragma unroll
            for (int j = 0; j < 4; ++j) o[64 * j] = (v[e][j] * rstd) * gv[j]; }
    }
}

struct Args { const float* in[23]; float* out; unsigned char* ws; };
#define AS4 __attribute__((address_space(4)))
__device__ __forceinline__ const AS4 Args* kargs() { const AS4 Args* p = (const AS4 Args*)__builtin_amdgcn_kernarg_segment_ptr(); asm volatile("" : "+s"(p)); return p; }
#define KIN(i) (kargs()->in[i])
#define WSP(T, off) ((T*)(kargs()->ws + (off)))
#ifndef REP_CV
#define REP_CV 1
#endif
#ifndef REP_S1
#define REP_S1 1
#endif
#ifndef REP_S3
#define REP_S3 1
#endif
#ifndef REP_R1
#define REP_R1 1
#endif
#ifndef REP_SORT
#define REP_SORT 1
#endif
#ifndef UP_GHOST
#define UP_GHOST 0
#endif
#ifndef DOWN_GHOST
#define DOWN_GHOST 0
#endif
#ifndef REP_DOWN
#define REP_DOWN 1
#endif
#ifndef REP_COMB
#define REP_COMB 1
#endif
#ifndef REP_UP
#define REP_UP 1
#endif
#ifndef REP_N1
#define REP_N1 1
#endif
#ifndef REP_G1
#define REP_G1 1
#endif
#ifndef REP_G2
#define REP_G2 1
#endif
#ifndef REP_N2
#define REP_N2 1
#endif
#ifndef REP_G3
#define REP_G3 1
#endif
#ifndef REP_P0
#define REP_P0 1
#endif
__global__ void __launch_bounds__(NT, 2) fwd_kernel(Args args_unused) {
    extern __shared__ __attribute__((aligned(16))) unsigned char lds_raw[];
    Ctx X; X.lds = (LAS unsigned char*)lds_raw; X.tid = threadIdx.x; X.lane = X.tid & 63; X.wave = __builtin_amdgcn_readfirstlane(X.tid >> 6); X.G = gridDim.x; X.bid = blockIdx.x;
    volatile LAS unsigned* MISC = (volatile LAS unsigned*)(X.lds + MISC_OFF);
    for (int u = X.tid; u < (LDS_BYTES - LDSCTL_OFF) / 4; u += NT) ((LAS unsigned*)(X.lds + LDSCTL_OFF))[u] = 0u;
    __syncthreads();
    XcdBarrier bar = xcd_barrier_post(WSP(unsigned, WS_CTL) + CW_BAR, MISC + 8);
#define GRID_BAR() xcd_barrier(bar)

#ifndef NO_PH_MOD
    for (int _r = 0; _r < REP_P0; ++_r) p0_mod(fresh(X), KIN(1), KIN(2), KIN(3), WSP(float, WS_MOD));
#endif
#ifndef NO_PH_FOLD
    for (int _r = 0; _r < REP_P0; ++_r) p0_fold(fresh(X), KIN(6), KIN(7), WSP(float, WS_WF));
#endif
    for (int l = 0; l < 2; ++l) { p0_cvt(fresh(X), KIN(18) + (size_t)l * 131072, WSP(bf16, WS_KEYS) + (size_t)(l * 2 + 0) * 131072, 131072 / 8); p0_cvt(fresh(X), KIN(19) + (size_t)l * 131072, WSP(bf16, WS_KEYS) + (size_t)(l * 2 + 1) * 131072, 131072 / 8); }
    GRID_BAR();
#ifndef NO_PH_TR
    for (int _r = 0; _r < REP_P0; ++_r) p0_transposes(fresh(X), KIN(6), WSP(float, WS_WF), KIN(16), KIN(17), WSP(bf16, WS_WIN), WSP(bf16, WS_WOUT), WSP(bf16, WS_WQ));
#endif
    __syncthreads();

    for (int l = 0; l < 2; ++l) {
        for (int _r = 0; _r < REP_N1; ++_r) {
            const float* xin = (l == 0) ? KIN(0) : WSP(float, WS_X2); const float* modl = WSP(float, WS_MOD) + (size_t)l * 4 * 6144;
            norm_mod_phase(fresh(X), xin, KIN(4) + l * DM, modl + 0 * DM, modl + 1 * DM, WSP(bf16, WS_XN));
        }
        GRID_BAR();
        for (int _r = 0; _r < REP_G1; ++_r) {
            pg8::Gemm g{WSP(bf16, WS_XN), WSP(bf16, WS_WIN) + (size_t)l * NPROJ_PAD * 1024, M, PROJ_LD, DM}; const Ctx Y = fresh(X); pg8::StaticOrder S; S.init(M, PROJ_LD, Y.G, Y.bid);
            pg8::EpiStore E{WSP(bf16, WS_PROJ), PROJ_LD, 12, WSP(float, WS_DTRAW), 16, 16};
            pg8::gemm_phase<pg8::EpiStore, pg8::StaticOrder, true, true>(X.lds, g, S, E);
            dt_proj_phase(fresh(X), WSP(bf16, WS_XN), WSP(bf16, WS_WIN) + (size_t)l * NPROJ_PAD * 1024, WSP(float, WS_DTRAW));
        }
        GRID_BAR();
        for (int _r = 0; _r < REP_S1; ++_r) ssd_a_phase(fresh(X), kargs()->ws, KIN(10) + (size_t)l * 4 * 1536, KIN(11) + (size_t)l * 1536, KIN(12) + l * 16, KIN(13) + l * 16);
        GRID_BAR();
#ifndef NO_PH_S2
#ifdef GHOST_S2
        ssd_scan_phase(fresh(X), WSP(bf16, WS_ST), WSP(float, WS_CD), WSP(bf16, WS_PART));
#endif
        ssd_scan_phase(fresh(X), WSP(bf16, WS_ST), WSP(float, WS_CD), WSP(bf16, WS_ST));
#endif
        GRID_BAR();
        for (int _r = 0; _r < REP_S3; ++_r) ssd_c_phase(fresh(X), kargs()->ws, KIN(14) + l * 16);
        GRID_BAR();
#ifndef NO_PH_S4
        mix_finish_phase(fresh(X), WSP(bf16, WS_PROJ), WSP(float, WS_SSQ), KIN(15) + l * DM, KIN(8) + l * 512, KIN(9) + l * 512, WSP(bf16, WS_XN));
#endif
        GRID_BAR();
        for (int _r = 0; _r < REP_G2; ++_r) {
            const float* xin = (l == 0) ? KIN(0) : WSP(float, WS_X2);
            pg8::Gemm g{WSP(bf16, WS_XN), WSP(bf16, WS_WOUT) + (size_t)l * 1024 * NMIX, M, DM, NMIX}; const Ctx Y = fresh(X); pg8::StaticOrder S; S.init(M, DM, Y.G, Y.bid);
            pg8::EpiResid E{xin, kargs()->out, WSP(float, WS_MOD) + (size_t)l * 4 * 6144 + 2 * DM};
            pg8::gemm_phase<pg8::EpiResid, pg8::StaticOrder, true, true>(X.lds, g, S, E);
        }
        GRID_BAR();
        for (int _r = 0; _r < REP_N2; ++_r) {
            const float* modl = WSP(float, WS_MOD) + (size_t)l * 4 * 6144;
            norm_mod_phase(fresh(X), kargs()->out, KIN(5) + l * DM, modl + 3 * DM, modl + 4 * DM, WSP(bf16, WS_XN));
        }
        GRID_BAR();
        for (int _r = 0; _r < REP_G3; ++_r) {
            pg8::Gemm g{WSP(bf16, WS_XN), WSP(bf16, WS_WQ) + (size_t)l * NQ * 1024, M, NQ, DM}; const Ctx Y = fresh(X); pg8::StaticOrder S; S.init(M, NQ, Y.G, Y.bid);
            pg8::EpiStore E{WSP(bf16, WS_PROJ), NQ, 1 << 30, nullptr, 0, 0};
            pg8::gemm_phase<pg8::EpiStore, pg8::StaticOrder, true, true>(X.lds, g, S, E);
        }
        GRID_BAR();
#ifndef NO_PH_R1
        for (int _r = 0; _r < REP_R1; ++_r) route_phase(fresh(X), WSP(bf16, WS_PROJ), WSP(bf16, WS_KEYS) + (size_t)l * 2 * 131072, WSP(int, WS_IDX), WSP(float, WS_GATE));
#endif
        GRID_BAR();
        for (int _r = 0; _r < REP_SORT; ++_r) peer_sort_phase(fresh(X), WSP(int, WS_IDX), WSP(float, WS_GATE), WSP(int, WS_ENT), WSP(float, WS_GS), WSP(unsigned short, WS_OFF));
        GRID_BAR();
        for (int _r = 0; _r < REP_DOWN; ++_r) peer_down_phase(fresh(X), KIN(20) + (size_t)l * 16384 * 1024, WSP(bf16, WS_XN), WSP(int, WS_ENT), WSP(unsigned short, WS_OFF), WSP(unsigned, WS_LIST), WSP(float, WS_PART), _r == 0 ? 0 : DOWN_GHOST);
        GRID_BAR();
        for (int _r = 0; _r < REP_COMB; ++_r) peer_combine_phase(fresh(X), WSP(float, WS_PART), WSP(float, WS_GS), WSP(int, WS_ENT), WSP(unsigned, WS_STREAM), KIN(21) + (size_t)l * 16384 * 1024);
        GRID_BAR();
        for (int _r = 0; _r < REP_UP; ++_r) peer_up_phase(fresh(X), KIN(21) + (size_t)l * 16384 * 1024, WSP(unsigned, WS_STREAM), kargs()->out, WSP(float, WS_MOD) + (size_t)l * 4 * 6144 + 5 * DM, _r == 0 ? WSP(float, WS_X2) : WSP(float, WS_PART), _r == 0 ? 0 : UP_GHOST);
        GRID_BAR();
#ifdef EXTRA_BARS
        for (int _e = 0; _e < EXTRA_BARS; ++_e) GRID_BAR();
#endif
        if (l == 1) final_norm_phase(fresh(X), WSP(float, WS_X2), KIN(22), kargs()->out);
    }
}

extern "C" void kernel_launch(void* const* d_in, const int* in_sizes, int n_in, void* d_out, int out_size, void* d_ws, size_t ws_size, hipStream_t stream) {
    static int grid = 0;
    if (grid == 0) {
        if (n_in != 23 || out_size != M * DM || ws_size < WS_END) { fprintf(stderr, "kernel_launch: unexpected shapes (n_in %d, out %d, ws %zu); nothing launched\n", n_in, out_size, ws_size); grid = -1; return; }
        int dev = 0, cus = 0, per_cu = 0;
        if (hipGetDevice(&dev) != hipSuccess || hipDeviceGetAttribute(&cus, hipDeviceAttributeMultiprocessorCount, dev) != hipSuccess) { grid = -1; return; }
        if (hipFuncSetAttribute((const void*)fwd_kernel, hipFuncAttributeMaxDynamicSharedMemorySize, LDS_BYTES) != hipSuccess) { fprintf(stderr, "kernel_launch: hipFuncSetAttribute failed\n"); grid = -1; return; }
        if (hipOccupancyMaxActiveBlocksPerMultiprocessor(&per_cu, (const void*)fwd_kernel, NT, LDS_BYTES) != hipSuccess || per_cu < 1) { fprintf(stderr, "kernel_launch: occupancy query says %d\n", per_cu); }
        (void)hipGetLastError();
        grid = cus;
    }
    if (grid < 0) return;
    if (hipMemsetAsync((char*)d_ws + WS_CTL, 0, CTL_ZERO_BYTES, stream) != hipSuccess) { fprintf(stderr, "kernel_launch: memset failed\n"); return; }
    Args a{};
    for (int i = 0; i < 23; ++i) a.in[i] = (const float*)d_in[i];
    a.out = (float*)d_out; a.ws = (unsigned char*)d_ws;
    hipLaunchKernelGGL(fwd_kernel, dim3(grid), dim3(NT), LDS_BYTES, stream, a);
}
```
